# Optimizing an MI355X kernel written in HIP

```python
import jax
import jax.numpy as jnp
from jax import lax
import numpy as np

D_MODEL = 2048
BATCH = 4
SEQ = 4096
DEPTH = 4

CTX_LEN = 256
GRID_W = 64
HEAD_DIM = 128
N_ATTN_HEADS = 12
N_KV_HEADS = 4
Q_PER_KV = N_ATTN_HEADS // N_KV_HEADS
ATTN_WIDTH = N_ATTN_HEADS * HEAD_DIM
KV_WIDTH = N_KV_HEADS * HEAD_DIM
ATTN_SCALE = HEAD_DIM ** -0.5
ROPE_THETA = 10000.0
Q_BLOCK = 128
FOURIER_WIDTH = D_MODEL - ATTN_WIDTH
N_FOURIER_GROUPS = 4
FOURIER_GROUP = FOURIER_WIDTH // N_FOURIER_GROUPS
Q_END = ATTN_WIDTH
K_END = Q_END + KV_WIDTH
V_END = K_END + KV_WIDTH
IN_WIDTH = V_END + FOURIER_WIDTH
RWKV_HEAD = 64
RWKV_HEADS = D_MODEL // RWKV_HEAD
DECAY_LORA = 96
ICLR_LORA = 96
VRES_LORA = 64
GATE_LORA = 256
N_DIRS = 2
GN_EPS = 64e-5
D_FF = 5632
CONV_W = 3
NORM_EPS = 1e-6
N_EVEN = (DEPTH + 1) // 2
N_ODD = DEPTH // 2
N_VRES = N_ODD - 1

kernel_name = 'hybrid_attn_fourier_rwkv7_dit_trunk'


def rms_norm(x, g):
    xf = x.astype(jnp.float32)
    y = xf * lax.rsqrt(jnp.mean(xf * xf, axis=-1, keepdims=True) + NORM_EPS)
    return (y * g.astype(jnp.float32)).astype(x.dtype)


def modulate(h, shift, scale):
    return h * (1 + scale) + shift


def axial_rope_tables(n_tokens):
    ROWS = n_tokens // GRID_W
    row = jnp.repeat(jnp.arange(ROWS, dtype=jnp.float32), GRID_W)
    col = jnp.tile(jnp.arange(GRID_W, dtype=jnp.float32), ROWS)
    axis_dim = HEAD_DIM // 2
    inv_freq = ROPE_THETA ** (-jnp.arange(0, axis_dim, 2, dtype=jnp.float32) / axis_dim)
    ang = jnp.concatenate([row[:, None] * inv_freq, col[:, None] * inv_freq], axis=-1)
    return jnp.cos(ang), jnp.sin(ang)


def apply_rope(x, cos, sin):
    xf = x.astype(jnp.float32).reshape(*x.shape[:-1], HEAD_DIM // 2, 2)
    x0, x1 = xf[..., 0], xf[..., 1]
    c = cos[None, :, None, :]
    s = sin[None, :, None, :]
    out = jnp.stack([x0 * c - x1 * s, x0 * s + x1 * c], axis=-1)
    return out.reshape(x.shape).astype(x.dtype)


def gqa_attend(q, k, v):
    s = jnp.einsum('bqngd,bsnd->bngqs', q, k).astype(jnp.float32) * ATTN_SCALE
    p = jax.nn.softmax(s, axis=-1).astype(v.dtype)
    return jnp.einsum('bngqs,bsnd->bqngd', p, v)


def fourier_mix(f):
    bsz, n, _ = f.shape
    fg = f.astype(jnp.float32).reshape(bsz, n, N_FOURIER_GROUPS, FOURIER_GROUP)
    out = jnp.fft.fft2(fg, axes=(1, 3), norm='ortho').real
    return out.astype(f.dtype).reshape(bsz, n, FOURIER_WIDTH)


def attn_fourier_mixer(h_ctx, h_lat, rope_cos, rope_sin, w_in, w_out, q_g, k_g):
    def project(h):
        bsz, n, _ = h.shape
        u = h @ w_in
        q = rms_norm(u[..., :Q_END].reshape(bsz, n, N_ATTN_HEADS, HEAD_DIM), q_g)
        k = rms_norm(u[..., Q_END:K_END].reshape(bsz, n, N_KV_HEADS, HEAD_DIM), k_g)
        v = u[..., K_END:V_END].reshape(bsz, n, N_KV_HEADS, HEAD_DIM)
        return q, k, v, u[..., V_END:]

    def group(q):
        return q.reshape(*q.shape[:2], N_KV_HEADS, Q_PER_KV, HEAD_DIM)

    bsz, n_ctx, _ = h_ctx.shape
    n_lat = h_lat.shape[1]
    q_c, k_c, v_c, f_c = project(h_ctx)
    q_l, k_l, v_l, f_l = project(h_lat)
    q_l = apply_rope(q_l, rope_cos, rope_sin)
    k_l = apply_rope(k_l, rope_cos, rope_sin)
    o_c = gqa_attend(group(q_c), k_c, v_c).reshape(bsz, n_ctx, ATTN_WIDTH)
    k_all = jnp.concatenate([k_c, k_l], axis=1)
    v_all = jnp.concatenate([v_c, v_l], axis=1)
    n_blk = n_lat // Q_BLOCK
    q_blocks = jnp.moveaxis(group(q_l).reshape(bsz, n_blk, Q_BLOCK, N_KV_HEADS, Q_PER_KV, HEAD_DIM), 1, 0)
    o_l = lax.map(lambda qb: gqa_attend(qb, k_all, v_all), q_blocks)
    o_l = jnp.moveaxis(o_l, 0, 1).reshape(bsz, n_lat, ATTN_WIDTH)
    y_c = jnp.concatenate([o_c, fourier_mix(f_c)], axis=-1) @ w_out
    y_l = jnp.concatenate([o_l, fourier_mix(f_l)], axis=-1) @ w_out
    return y_c, y_l


def centred_shift(x):
    xp = jnp.pad(x, ((0, 0), (1, 1), (0, 0)))
    return 0.5 * (xp[:, :-2] + xp[:, 2:]) - x


def wkv7_scan(r, w, k, v, a, b):
    _, bsz, nh, hd = r.shape

    def step(state, inp):
        r_t, w_t, k_t, v_t, a_t, b_t = inp
        sa = jnp.einsum('bhvk,bhk->bhv', state, a_t)
        state = (state * w_t[:, :, None, :] + sa[..., None] * b_t[:, :, None, :]
                 + v_t[..., None] * k_t[:, :, None, :])
        return state, jnp.einsum('bhvk,bhk->bhv', state, r_t)

    _, y = lax.scan(step, jnp.zeros((bsz, nh, hd, hd), jnp.float32), (r, w, k, v, a, b))
    return y


def rwkv7_mixer(h_ctx, h_lat, v_first, vres, mu, w_r, w_k, w_v, w_o, decay_w0, decay_w1, decay_w2,
                iclr_a0, iclr_a1, iclr_a2, gate_g1, gate_g2, k_k, k_a, r_k, lnx_g, lnx_b):
    bsz, n_ctx, _ = h_ctx.shape
    n_tot = n_ctx + h_lat.shape[1]
    h = jnp.concatenate([h_ctx, h_lat], axis=1)
    dx = jnp.concatenate([centred_shift(h_ctx), centred_shift(h_lat)], axis=1)
    x_r, x_w, x_k, x_v, x_a, x_g = [h + dx * mu[m] for m in range(6)]
    r = x_r @ w_r
    k = x_k @ w_k
    v = x_v @ w_v
    if vres is None:
        v_first = v
    else:
        v0, v1, v2 = vres
        v = v + (v_first - v) * jax.nn.sigmoid(v0 + (x_v @ v1) @ v2)
    g = jax.nn.sigmoid(x_g @ gate_g1) @ gate_g2

    def heads(t):
        return t.astype(jnp.float32).reshape(bsz, n_tot, RWKV_HEADS, RWKV_HEAD)

    def seg_flip(t):
        return jnp.concatenate([jnp.flip(t[:, :n_ctx], 1), jnp.flip(t[:, n_ctx:], 1)], axis=1)

    r_h, v_h, k_h = heads(r), heads(v), heads(k)
    kk = heads(k * k_k)
    kk = kk / jnp.maximum(jnp.linalg.norm(kk, axis=-1, keepdims=True), 1e-12)
    ka_h = k_a.astype(jnp.float32).reshape(RWKV_HEADS, RWKV_HEAD)
    rk_h = r_k.astype(jnp.float32)
    ys, bonuses = [], []
    for d in range(N_DIRS):
        w_log = -jax.nn.softplus(-(decay_w0[d] + jnp.tanh(x_w @ decay_w1[d]) @ decay_w2[d])) - 0.5
        decay = jnp.exp(-jnp.exp(heads(w_log)))
        a = jax.nn.sigmoid(heads(iclr_a0[d] + (x_a @ iclr_a1[d]) @ iclr_a2[d]))
        k_d = k_h * (1 + (a - 1) * ka_h)
        seqs = (r_h, decay, k_d, v_h, -kk, kk * a)
        if d == 1:
            seqs = tuple(seg_flip(t) for t in seqs)
        y = jnp.moveaxis(wkv7_scan(*(jnp.moveaxis(t, 1, 0) for t in seqs)), 0, 1)
        if d == 1:
            y = seg_flip(y)
        ys.append(y)
        bonuses.append(jnp.sum(r_h * k_d * rk_h, axis=-1, keepdims=True) * v_h)
    wkv = ys[0] + ys[1]
    mean = jnp.mean(wkv, axis=-1, keepdims=True)
    var = jnp.var(wkv, axis=-1, keepdims=True)
    normed = ((wkv - mean) * lax.rsqrt(var + GN_EPS)).reshape(bsz, n_tot, D_MODEL) * lnx_g + lnx_b
    bonus = (bonuses[0] + bonuses[1]).reshape(bsz, n_tot, D_MODEL)
    out = ((normed + bonus) * g).astype(h.dtype) @ w_o
    return out[:, :n_ctx], out[:, n_ctx:], v_first


def conv_gated_ffn(h, w_up, conv_w, conv_b, w_down):
    n = h.shape[1]
    u = jnp.pad(h @ w_up, ((0, 0), (CONV_W // 2, CONV_W // 2), (0, 0)))
    u = sum((u[:, t:t + n] * conv_w[t] for t in range(CONV_W)), conv_b)
    gate, val = jnp.split(u, 2, axis=-1)
    return (jax.nn.silu(gate) * val) @ w_down


def setup_inputs(seed: int = 0) -> dict:
    key = jax.random.key(seed)
    ks = iter(jax.random.split(key, 48))
    f32 = jnp.float32
    D = D_MODEL

    def nrm(shape, scale):
        return scale * jax.random.normal(next(ks), shape, f32)

    def uni(shape, lo, hi):
        return jax.random.uniform(next(ks), shape, f32, lo, hi)

    return {
        'x': nrm((BATCH, SEQ, D), 1.0),
        'c': nrm((BATCH, D), 1.0),
        'ctx': nrm((BATCH, CTX_LEN, D), 1.0),
        'c_ctx': nrm((D,), 1.0),
        'w_mod': nrm((DEPTH, D, 6 * D), 0.5 * D ** -0.5),
        'b_mod': nrm((DEPTH, 6 * D), 0.01),
        'norm1_g': 1.0 + nrm((DEPTH, D), 0.05),
        'norm2_g': 1.0 + nrm((DEPTH, D), 0.05),
        'attn_w_in': nrm((N_EVEN, D, IN_WIDTH), D ** -0.5),
        'attn_w_out': nrm((N_EVEN, D, D), D ** -0.5),
        'q_norm_g': 1.0 + nrm((N_EVEN, HEAD_DIM), 0.05),
        'k_norm_g': 1.0 + nrm((N_EVEN, HEAD_DIM), 0.05),
        'rwkv_mu': uni((N_ODD, 6, D), 0.0, 1.0),
        'rwkv_w_r': nrm((N_ODD, D, D), D ** -0.5),
        'rwkv_w_k': nrm((N_ODD, D, D), D ** -0.5),
        'rwkv_w_v': nrm((N_ODD, D, D), D ** -0.5),
        'rwkv_w_o': nrm((N_ODD, D, D), D ** -0.5),
        'rwkv_decay_w0': uni((N_ODD, N_DIRS, D), -6.0, 1.0),
        'rwkv_decay_w1': nrm((N_ODD, N_DIRS, D, DECAY_LORA), D ** -0.5),
        'rwkv_decay_w2': nrm((N_ODD, N_DIRS, DECAY_LORA, D), 0.1 * DECAY_LORA ** -0.5),
        'rwkv_iclr_a0': nrm((N_ODD, N_DIRS, D), 0.1),
        'rwkv_iclr_a1': nrm((N_ODD, N_DIRS, D, ICLR_LORA), D ** -0.5),
        'rwkv_iclr_a2': nrm((N_ODD, N_DIRS, ICLR_LORA, D), 0.1 * ICLR_LORA ** -0.5),
        'rwkv_gate_g1': nrm((N_ODD, D, GATE_LORA), D ** -0.5),
        'rwkv_gate_g2': nrm((N_ODD, GATE_LORA, D), GATE_LORA ** -0.5),
        'rwkv_k_k': 0.85 + nrm((N_ODD, D), 0.05),
        'rwkv_k_a': 1.0 + nrm((N_ODD, D), 0.05),
        'rwkv_r_k': nrm((N_ODD, RWKV_HEADS, RWKV_HEAD), 0.1),
        'rwkv_lnx_g': 1.0 + nrm((N_ODD, D), 0.05),
        'rwkv_lnx_b': nrm((N_ODD, D), 0.01),
        'rwkv_vres_v0': 1.0 + nrm((N_VRES, D), 0.1),
        'rwkv_vres_v1': nrm((N_VRES, D, VRES_LORA), D ** -0.5),
        'rwkv_vres_v2': nrm((N_VRES, VRES_LORA, D), 0.1 * VRES_LORA ** -0.5),
        'ffn_w_up': nrm((DEPTH, D, 2 * D_FF), D ** -0.5),
        'ffn_conv_w': nrm((DEPTH, CONV_W, 2 * D_FF), CONV_W ** -0.5),
        'ffn_conv_b': nrm((DEPTH, 2 * D_FF), 0.01),
        'ffn_w_down': nrm((DEPTH, D_FF, D), D_FF ** -0.5),
        'final_norm_g': 1.0 + nrm((D,), 0.05),
    }


def reference(x, c, ctx, c_ctx, w_mod, b_mod, norm1_g, norm2_g, attn_w_in, attn_w_out, q_norm_g, k_norm_g,
              rwkv_mu, rwkv_w_r, rwkv_w_k, rwkv_w_v, rwkv_w_o, rwkv_decay_w0, rwkv_decay_w1, rwkv_decay_w2,
              rwkv_iclr_a0, rwkv_iclr_a1, rwkv_iclr_a2, rwkv_gate_g1, rwkv_gate_g2, rwkv_k_k, rwkv_k_a, rwkv_r_k,
              rwkv_lnx_g, rwkv_lnx_b, rwkv_vres_v0, rwkv_vres_v1, rwkv_vres_v2,
              ffn_w_up, ffn_conv_w, ffn_conv_b, ffn_w_down, final_norm_g):
    rope_cos, rope_sin = axial_rope_tables(x.shape[1])
    silu_c = jax.nn.silu(c)
    silu_cc = jax.nn.silu(c_ctx)
    x_lat, x_ctx = x, ctx
    v_first = None
    for i in range(DEPTH):
        last = i == DEPTH - 1
        j = i // 2
        m_lat = jnp.split((silu_c @ w_mod[i] + b_mod[i])[:, None, :], 6, axis=-1)
        m_ctx = jnp.split((silu_cc @ w_mod[i] + b_mod[i])[None, None, :], 6, axis=-1)
        h_lat = modulate(rms_norm(x_lat, norm1_g[i]), m_lat[0], m_lat[1])
        h_ctx = modulate(rms_norm(x_ctx, norm1_g[i]), m_ctx[0], m_ctx[1])
        if i % 2 == 0:
            y_ctx, y_lat = attn_fourier_mixer(h_ctx, h_lat, rope_cos, rope_sin, attn_w_in[j], attn_w_out[j],
                                              q_norm_g[j], k_norm_g[j])
        else:
            vres = None if j == 0 else (rwkv_vres_v0[j - 1], rwkv_vres_v1[j - 1], rwkv_vres_v2[j - 1])
            y_ctx, y_lat, v_first = rwkv7_mixer(
                h_ctx, h_lat, v_first, vres, rwkv_mu[j], rwkv_w_r[j], rwkv_w_k[j], rwkv_w_v[j], rwkv_w_o[j],
                rwkv_decay_w0[j], rwkv_decay_w1[j], rwkv_decay_w2[j], rwkv_iclr_a0[j], rwkv_iclr_a1[j],
                rwkv_iclr_a2[j], rwkv_gate_g1[j], rwkv_gate_g2[j], rwkv_k_k[j], rwkv_k_a[j], rwkv_r_k[j],
                rwkv_lnx_g[j], rwkv_lnx_b[j])
        x_lat = x_lat + m_lat[2] * y_lat
        h_lat = modulate(rms_norm(x_lat, norm2_g[i]), m_lat[3], m_lat[4])
        x_lat = x_lat + m_lat[5] * conv_gated_ffn(h_lat, ffn_w_up[i], ffn_conv_w[i], ffn_conv_b[i], ffn_w_down[i])
        if not last:
            x_ctx = x_ctx + m_ctx[2] * y_ctx
            h_ctx = modulate(rms_norm(x_ctx, norm2_g[i]), m_ctx[3], m_ctx[4])
            x_ctx = x_ctx + m_ctx[5] * conv_gated_ffn(h_ctx, ffn_w_up[i], ffn_conv_w[i], ffn_conv_b[i],
                                                       ffn_w_down[i])
    return rms_norm(x_lat, final_norm_g)
```

```cpp
#include <hip/hip_runtime.h>
#include <cstdio>
#include <cstdint>

#define LAS __attribute__((address_space(3)))
typedef unsigned short bf16;
typedef short bf16x8 __attribute__((ext_vector_type(8)));
typedef short s16x4 __attribute__((ext_vector_type(4)));
typedef float f32x4 __attribute__((ext_vector_type(4)));
typedef float f32x16 __attribute__((ext_vector_type(16)));
typedef unsigned u32x4 __attribute__((ext_vector_type(4)));
typedef unsigned u32x2 __attribute__((ext_vector_type(2)));

constexpr int DM = 2048, NBATCH = 4, SEQ = 4096, CTXL = 256, TPB = SEQ + CTXL, NT = NBATCH * TPB, NPAN = NT / 256, PPB = TPB / 256;
constexpr int DFF = 5632, DFF2 = 11264, NQKV = 2560, TLD = 8704, WIN = 3072;
static_assert(NT == 17408 && NPAN == 68 && PPB == 17, "shapes");

constexpr size_t MiB = 1u << 20;
constexpr size_t WS_CTL = 0, CTL_ZERO_BYTES = 2 * MiB;
constexpr size_t WS_ROPEC = 2 * MiB, WS_ROPES = 3 * MiB;
constexpr size_t WS_WUP = 4 * MiB;
constexpr size_t WS_WDN = 180 * MiB;
constexpr size_t WS_WQKV = 268 * MiB;
constexpr size_t WS_WPQ = 288 * MiB;
constexpr size_t WS_WOUT = 296 * MiB;
constexpr size_t WS_WRKVO = 312 * MiB;
constexpr size_t WS_L1 = 376 * MiB;
constexpr size_t WS_L2 = 384 * MiB;
constexpr size_t WS_ADFT = 396 * MiB;
constexpr size_t WS_X = 464 * MiB;
constexpr size_t WS_H = 600 * MiB;
constexpr size_t WS_VFIRST = 668 * MiB;
constexpr size_t WS_BSUM = 736 * MiB;
constexpr size_t WS_SCR = 744 * MiB;
constexpr size_t WS_ACT = WS_SCR + 374 * MiB, WS_HALO = WS_SCR + 562 * MiB;
constexpr size_t WS_QKV = WS_SCR, WS_T = WS_SCR + 85 * MiB, WS_MIX = WS_SCR + 119 * MiB;
constexpr size_t WS_MIXES = WS_SCR, WS_R = WS_SCR + 408 * MiB, WS_K = WS_SCR + 476 * MiB, WS_V = WS_SCR + 544 * MiB, WS_L = WS_SCR + 612 * MiB, WS_Y = WS_SCR + 646 * MiB;
constexpr size_t WS_E = WS_SCR, WS_AA = WS_SCR + 136 * MiB, WS_G = WS_SCR + 272 * MiB, WS_OA = WS_R;
constexpr size_t WS_STATS = WS_L;
constexpr size_t WS_PART = WS_SCR + 200 * MiB;
constexpr size_t WS_END = WS_SCR + 782 * MiB;
constexpr size_t MIXSZ = 68 * MiB;
constexpr int CW_BAR = 4096;
constexpr int CW_MOD = 16384;

constexpr int RING_BYTES = 131072, MISC_OFF = RING_BYTES + 320, LDS_BYTES = 147456;

#define LDS_WAIT() asm volatile("s_waitcnt lgkmcnt(0)" ::: "memory")
#define VM_WAIT() asm volatile("s_waitcnt vmcnt(0)" ::: "memory")
__device__ __forceinline__ unsigned f2bf(float f) { unsigned u = __builtin_bit_cast(unsigned, f); return (u + 0x7fffu + ((u >> 16) & 1u)) >> 16; }
__device__ __forceinline__ float bf2f(unsigned short b) { return __builtin_bit_cast(float, ((unsigned)b) << 16); }
__device__ __forceinline__ float bflo(unsigned w) { return __builtin_bit_cast(float, w << 16); }
__device__ __forceinline__ float bfhi(unsigned w) { return __builtin_bit_cast(float, w & 0xffff0000u); }
typedef float f32x2_cv __attribute__((ext_vector_type(2)));
typedef __bf16 bf16x2_cv __attribute__((ext_vector_type(2)));
__device__ __forceinline__ unsigned cvt_pk_bf16(float lo, float hi) { const f32x2_cv v = {lo, hi}; const bf16x2_cv b = __builtin_convertvector(v, bf16x2_cv); return __builtin_bit_cast(unsigned, b); }
__device__ __forceinline__ unsigned pk2(float lo, float hi) { return cvt_pk_bf16(lo, hi); }
__device__ __forceinline__ unsigned short f2h(float f) { return __builtin_bit_cast(unsigned short, (_Float16)f); }
__device__ __forceinline__ float h2f(unsigned short h) { return (float)__builtin_bit_cast(_Float16, h); }
typedef _Float16 f16x2 __attribute__((ext_vector_type(2)));
__device__ __forceinline__ float hlo(unsigned w) { return (float)__builtin_bit_cast(f16x2, w)[0]; }
__device__ __forceinline__ float hhi(unsigned w) { return (float)__builtin_bit_cast(f16x2, w)[1]; }
__device__ __forceinline__ unsigned pk2h(float a, float b) { f16x2 v; v[0] = (_Float16)a; v[1] = (_Float16)b; return __builtin_bit_cast(unsigned, v); }
__device__ __forceinline__ float sigmoidf_(float x) { return __builtin_amdgcn_rcpf(1.0f + __expf(-x)); }
__device__ __forceinline__ float tanhf_(float x) { return 1.0f - 2.0f * __builtin_amdgcn_rcpf(1.0f + __builtin_amdgcn_exp2f(x * 2.8853900817779268f)); }
__device__ __forceinline__ int opaque_s(int x) { asm volatile("" : "+s"(x)); return x; }
__device__ __forceinline__ int opaque_tid(int wave) { int l; asm volatile("v_mbcnt_lo_u32_b32 %0, -1, 0\n\tv_mbcnt_hi_u32_b32 %0, -1, %0" : "=v"(l)); return wave * 64 + l; }
template <int CTRL> __device__ __forceinline__ float dpp_mov(float x) { return __builtin_bit_cast(float, __builtin_amdgcn_update_dpp(0, __builtin_bit_cast(int, x), CTRL, 0xF, 0xF, true)); }
__device__ __forceinline__ float wave_sum(float v) {
    v += dpp_mov<0xB1>(v); v += dpp_mov<0x4E>(v); v += dpp_mov<0x141>(v); v += dpp_mov<0x140>(v);
    const int iv = __builtin_bit_cast(int, v);
    const float r0 = __builtin_bit_cast(float, __builtin_amdgcn_readlane(iv, 0)), r1 = __builtin_bit_cast(float, __builtin_amdgcn_readlane(iv, 16));
    const float r2 = __builtin_bit_cast(float, __builtin_amdgcn_readlane(iv, 32)), r3 = __builtin_bit_cast(float, __builtin_amdgcn_readlane(iv, 48));
    return (r0 + r1) + (r2 + r3);
}

#define XB_TMO      128
#define XB_XCNT(j)  (256  + 64 * (j))
#define XB_XSUB(j)  (1280 + 64 * (j))
#define XB_XGEN(j)  (2304 + 64 * (j))
#define XB_TOP      3328
#define XB_TOPGEN   3392
#define XCD_BAR_WORDS 3456
#define XB_SPIN_CAP (1u << 18)
__device__ __forceinline__ unsigned xb_ld(unsigned* p)              { return __hip_atomic_load(p, __ATOMIC_RELAXED, __HIP_MEMORY_SCOPE_AGENT); }
__device__ __forceinline__ unsigned xb_add(unsigned* p, unsigned v) { return __hip_atomic_fetch_add(p, v, __ATOMIC_RELAXED, __HIP_MEMORY_SCOPE_AGENT); }
__device__ __forceinline__ unsigned xb_xcc_id() { return (unsigned)__builtin_amdgcn_s_getreg((3 << 11) | 20) & 0xFu; }
#define XB_SPIN(cond, bar) do { unsigned _sp = 0; while (cond) { __builtin_amdgcn_s_sleep(1); \
    if ((++_sp & 255u) == 0u) { if (xb_ld(&(bar)[XB_TMO])) break; if (_sp > XB_SPIN_CAP) { atomicAdd(&(bar)[XB_TMO], 1u); break; } } } } while (0)
struct XcdBarrier { unsigned* bar; unsigned x; volatile LAS unsigned* st; int wave; };
__device__ __forceinline__ XcdBarrier xcd_barrier_post(unsigned* bar, volatile LAS unsigned* st) {
    XcdBarrier b; b.wave = 0; b.bar = bar; b.x = (unsigned)__builtin_amdgcn_readfirstlane((int)xb_xcc_id()); b.st = st;
    if (threadIdx.x == 0) (void)xb_add(&bar[XB_XCNT(b.x)], 1u);
    return b;
}
__device__ __forceinline__ void xcd_barrier_complete(unsigned* bar, unsigned x, unsigned& nloc, unsigned& nx) {
    const unsigned G = gridDim.x * gridDim.y * gridDim.z;
    unsigned sum, cnt, mine, sp = 0u;
    for (;;) {
        sum = 0u; cnt = 0u; mine = 0u;
#pragma unroll
        for (unsigned j = 0; j < 16; ++j) { const unsigned c = xb_ld(&bar[XB_XCNT(j)]); sum += c; cnt += (c > 0u) ? 1u : 0u; mine = (j == x) ? c : mine; }
        if (sum == G) break;
        __builtin_amdgcn_s_sleep(1);
        if ((++sp & 255u) == 0u) { if (xb_ld(&bar[XB_TMO])) break; if (sp > XB_SPIN_CAP) { atomicAdd(&bar[XB_TMO], 1u); break; } }
    }
    nloc = mine > 0u ? mine : 1u; nx = cnt > 0u ? cnt : 1u;
}
__device__ __forceinline__ void xcd_barrier(const XcdBarrier& b) {
    asm volatile("s_waitcnt vmcnt(0)" ::: "memory");
    __syncthreads();
    if (opaque_tid(b.wave) == 0) {
        unsigned* bar = b.bar;
        unsigned bx_ = (unsigned)__builtin_amdgcn_readfirstlane((int)xb_xcc_id()); asm volatile("" : "+s"(bx_));
        __builtin_amdgcn_s_waitcnt(0);
        unsigned nloc = b.st[0], nx = b.st[1];
        if (nloc == 0u) { xcd_barrier_complete(bar, bx_, nloc, nx); b.st[0] = nloc; b.st[1] = nx; }
        const unsigned old = xb_add(&bar[XB_XSUB(bx_)], 1u);
        const unsigned gen = old / nloc;
        if (old + 1u == (gen + 1u) * nloc) {
            __builtin_amdgcn_fence(__ATOMIC_RELEASE, "agent");
            asm volatile("s_waitcnt vmcnt(0)" ::: "memory");
            const unsigned og = xb_add(&bar[XB_TOP], 1u);
            const unsigned tg = og / nx;
            if (og + 1u == (tg + 1u) * nx) xb_add(&bar[XB_TOPGEN], 1u);
            else XB_SPIN(xb_ld(&bar[XB_TOPGEN]) == tg, bar);
            __builtin_amdgcn_fence(__ATOMIC_ACQUIRE, "agent");
            xb_add(&bar[XB_XGEN(bx_)], 1u);
            asm volatile("s_waitcnt vmcnt(0)" ::: "memory");
        } else {
            XB_SPIN(xb_ld(&bar[XB_XGEN(bx_)]) == gen, bar);
            __builtin_amdgcn_fence(__ATOMIC_ACQUIRE, "agent");
            asm volatile("s_waitcnt vmcnt(0)" ::: "memory");
        }
    }
    __syncthreads();
}

namespace pg8 {
constexpr int BM = 256, BK = 64, HALF = 128, HTB = HALF * BK * 2, STAGE_BYTES = 8 * HTB;
__device__ __forceinline__ int lds_byte(int r, int c) { const int st = (r >> 4) * 2 + (c >> 5), rr = r & 15, cc = c & 31, ob = rr * 64 + cc * 2; return st * 1024 + (ob ^ (((ob >> 9) & 1) << 5)); }
__device__ __forceinline__ void stage_rc(int b, int& R, int& C) { const int st = b / 1024, sb = b % 1024, swz = sb ^ (((sb >> 9) & 1) << 5); R = (st >> 1) * 16 + swz / 64; C = (st & 1) * 32 + (swz % 64) / 2; }
__device__ __forceinline__ int perm32(int rho) { const int n = rho >> 4, i = rho & 15; return 8 * (i >> 2) + 4 * n + (i & 3); }

struct Unit { const char* A; const char* B; int nt, pm, pn, kind; };

__device__ __forceinline__ bool tile_of(long L, int nM, int nN, int& pm, int& pn) {
    const int nwg = nM * nN; if (L >= nwg) return false;
    int wgid = (int)L; { const int q = nwg / 8, r = nwg % 8, xcd = wgid % 8, off = wgid / 8; wgid = (xcd < r ? xcd * (q + 1) : r * (q + 1) + (xcd - r) * q) + off; }
    const int nig = 8 * nN, gid = wgid / nig, fm = gid * 8, gsz = (nM - fm) < 8 ? (nM - fm) : 8;
    pm = fm + ((wgid % nig) % gsz); pn = (wgid % nig) / gsz; return true;
}

template <class Epi, class Sched>
__device__ __forceinline__ void gemm_phase(LAS unsigned char* lds, const int wave_, const int lda, const int ldb, const Sched& S, const Epi& E) {
    const int wid = opaque_s(wave_), tid = opaque_tid(wid), lane = tid & 63, wr = wid >> 2, wc = wid & 3, fr = lane & 15, fq = lane >> 4;
    unsigned voffA[2], voffB[2];
#pragma unroll
    for (int i = 0; i < 2; ++i) { int R, C; stage_rc(tid * 16 + i * 8192, R, C); const int Rb = Epi::PERM ? ((R & ~31) + perm32(R & 31)) : R;
        voffA[i] = (unsigned)(R * lda + C) * 2u; voffB[i] = (unsigned)(Rb * ldb + C) * 2u; }
    const size_t kstep = (size_t)(BK * 2);
    const size_t hstepA = (size_t)HALF * lda * 2, hstepB = (size_t)HALF * ldb * 2;
    const unsigned ldsw = (unsigned)wid * 1024u;
    const int aoff = lds_byte(wr * 64 + fr, fq * 8), boff = lds_byte(wc * 32 + fr, fq * 8);
#define PG8_SA(b, h) (((b) * 2 + (h)) * HTB)
#define PG8_SB(b, h) ((4 + (b) * 2 + (h)) * HTB)
#define PG8_STAGE(bufoff, gbase, voff) do { _Pragma("unroll") for (int _i = 0; _i < 2; ++_i) \
        __builtin_amdgcn_global_load_lds((const unsigned*)((const char*)(gbase) + (voff)[_i]), (LAS unsigned*)(lds + (bufoff) + ldsw + _i * 8192), 16, 0, 0); } while (0)
#define PG8_LDA(dst, b, h) do { _Pragma("unroll") for (int m = 0; m < 4; ++m) _Pragma("unroll") for (int k = 0; k < 2; ++k) dst[m][k] = *(const LAS bf16x8*)(lds + PG8_SA(b, h) + aoff + m * 2048 + k * 1024); } while (0)
#define PG8_LDB(dst, b, h) do { _Pragma("unroll") for (int n = 0; n < 2; ++n) _Pragma("unroll") for (int k = 0; k < 2; ++k) dst[n][k] = *(const LAS bf16x8*)(lds + PG8_SB(b, h) + boff + n * 2048 + k * 1024); } while (0)
#define PG8_MMA(ai, bj, At, Bt) do { __builtin_amdgcn_s_setprio(1); _Pragma("unroll") for (int m = 0; m < 4; ++m) _Pragma("unroll") for (int n = 0; n < 2; ++n) _Pragma("unroll") for (int k = 0; k < 2; ++k) \
        acc[ai][bj][m][n] = __builtin_amdgcn_mfma_f32_16x16x32_bf16(Bt[n][k], At[m][k], acc[ai][bj][m][n], 0, 0, 0); __builtin_amdgcn_s_setprio(0); } while (0)
#define PG8_WAIT_V(n) asm volatile("s_waitcnt vmcnt(" #n ")" ::: "memory")
#define PG8_WAIT_L(n) asm volatile("s_waitcnt lgkmcnt(" #n ")" ::: "memory")
#define PG8_BAR __builtin_amdgcn_s_barrier()
#define PG8_SCHED __builtin_amdgcn_sched_barrier(0)
    Unit cur, nxt; int ui = 0;
    if (!S.next(0, cur)) return;
    f32x4 acc[2][2][4][2];
#pragma unroll
    for (int a = 0; a < 2; ++a)
#pragma unroll
        for (int b = 0; b < 2; ++b)
#pragma unroll
            for (int m = 0; m < 4; ++m)
#pragma unroll
                for (int n = 0; n < 2; ++n) acc[a][b][m][n] = (f32x4){0.f, 0.f, 0.f, 0.f};
    bf16x8 At[4][2], B0[2][2], B1[2][2];
    const char* cA = cur.A; const char* cB = cur.B;
    PG8_STAGE(PG8_SB(0, 0), cB, voffB); PG8_STAGE(PG8_SB(0, 1), cB + hstepB, voffB); PG8_STAGE(PG8_SA(0, 0), cA, voffA); PG8_STAGE(PG8_SA(0, 1), cA + hstepA, voffA);
    if (wr == 1) PG8_BAR;
    PG8_WAIT_V(2); PG8_BAR;
    PG8_STAGE(PG8_SB(1, 0), cB + kstep, voffB); PG8_STAGE(PG8_SA(1, 0), cA + kstep, voffA); PG8_STAGE(PG8_SB(1, 1), cB + hstepB + kstep, voffB);
    PG8_WAIT_V(6); PG8_BAR;
    for (;;) {
        const bool has_next = S.next(ui + 1, nxt);
        const char* nA = has_next ? nxt.A : cA; const char* nB = has_next ? nxt.B : cB;
        const int nt = opaque_s(cur.nt);
        for (int t = 0; t < nt; t += 2) {
            const bool last = (t == nt - 2);
            const char* a1 = cA + (size_t)(t + 1) * kstep;
            const char* a2 = last ? nA : cA + (size_t)(t + 2) * kstep; const char* b2 = last ? nB : cB + (size_t)(t + 2) * kstep;
            const char* a3 = a2 + kstep; const char* b3 = b2 + kstep;
            PG8_LDB(B0, 0, 0); PG8_LDB(B1, 0, 1); PG8_SCHED; PG8_LDA(At, 0, 0); PG8_STAGE(PG8_SA(1, 1), a1 + hstepA, voffA);
            PG8_WAIT_V(8); PG8_WAIT_L(0); PG8_BAR; PG8_MMA(0, 0, At, B0); PG8_MMA(0, 1, At, B1); PG8_BAR; PG8_SCHED;
            PG8_LDA(At, 0, 1); PG8_STAGE(PG8_SB(0, 0), b2, voffB); PG8_STAGE(PG8_SB(0, 1), b2 + hstepB, voffB); PG8_STAGE(PG8_SA(0, 0), a2, voffA);
            PG8_WAIT_V(8); PG8_WAIT_L(0); PG8_BAR; PG8_MMA(1, 0, At, B0); PG8_MMA(1, 1, At, B1); PG8_BAR; PG8_SCHED;
            PG8_LDB(B0, 1, 0); PG8_LDB(B1, 1, 1); PG8_SCHED; PG8_LDA(At, 1, 0); PG8_STAGE(PG8_SA(0, 1), a2 + hstepA, voffA);
            PG8_WAIT_V(8); PG8_WAIT_L(0); PG8_BAR; PG8_MMA(0, 0, At, B0); PG8_MMA(0, 1, At, B1); PG8_BAR; PG8_SCHED;
            PG8_LDA(At, 1, 1); PG8_STAGE(PG8_SB(1, 0), b3, voffB); PG8_STAGE(PG8_SB(1, 1), b3 + hstepB, voffB); PG8_STAGE(PG8_SA(1, 0), a3, voffA);
            PG8_WAIT_V(8); PG8_WAIT_L(0); PG8_BAR; PG8_MMA(1, 0, At, B0); PG8_MMA(1, 1, At, B1); PG8_BAR; PG8_SCHED;
        }
        if (wr == 0) PG8_BAR;
        E(acc, cur, wr, wc, fr, fq);
        if (!has_next) break;
#pragma unroll
        for (int a = 0; a < 2; ++a)
#pragma unroll
            for (int b = 0; b < 2; ++b)
#pragma unroll
                for (int m = 0; m < 4; ++m)
#pragma unroll
                    for (int n = 0; n < 2; ++n) acc[a][b][m][n] = (f32x4){0.f, 0.f, 0.f, 0.f};
        cur = nxt; cA = nA; cB = nB; ++ui;
        if (wr == 1) PG8_BAR;
    }
    PG8_WAIT_V(0);
    PG8_BAR;
#undef PG8_SA
#undef PG8_SB
#undef PG8_STAGE
#undef PG8_LDA
#undef PG8_LDB
#undef PG8_MMA
#undef PG8_WAIT_V
#undef PG8_WAIT_L
#undef PG8_BAR
#undef PG8_SCHED
}

struct SchedSimple {
    const char* A; const char* B; size_t astep, bstep; int nM, nN, nt, G, c;
    __device__ __forceinline__ bool next(int i, Unit& u) const {
        int pm, pn; if (!tile_of((long)i * G + c, nM, nN, pm, pn)) return false;
        if (nM == 64) pm = (pm >> 4) * PPB + 1 + (pm & 15);
        u.A = A + (size_t)pm * astep; u.B = B + (size_t)pn * bstep; u.nt = nt; u.pm = pm; u.pn = pn; u.kind = 0; return true; }
};
struct SchedRes {
    const char* A; const char* B; size_t astep, bstep; int nt, lat_only, G, c;
    __device__ __forceinline__ bool next(int i, Unit& u) const {
        const long L = (long)i * G + c;
        if (L < 512) { int pl, pn; tile_of(L, 64, 8, pl, pn); const int pm = (pl >> 4) * PPB + 1 + (pl & 15);
            u.A = A + (size_t)pm * astep; u.B = B + (size_t)pn * bstep; u.nt = nt; u.pm = pm; u.pn = pn; u.kind = 0; return true; }
        if (lat_only || L >= 768) return false;
        const int s = (int)L - 512, sl = s >> 5, cu = s & 31, b = cu >> 3, pn = cu & 7, pm = b * PPB;
        int t0, n;
        if (nt == 32) { t0 = 4 * sl; n = 4; } else { t0 = (sl < 4) ? 12 * sl : 48 + 10 * (sl - 4); n = (sl < 4) ? 12 : 10; }
        u.A = A + (size_t)pm * astep + (size_t)t0 * 128; u.B = B + (size_t)pn * bstep + (size_t)t0 * 128; u.nt = n; u.pm = pm; u.pn = pn; u.kind = 1 + sl; return true; }
};
struct SchedInproj {
    const char* H; const char* Wqkv; const char* Wpq; int G, c;
    __device__ __forceinline__ bool next(int i, Unit& u) const {
        int tp, ft; if (!tile_of((long)i * G + c, NPAN, 14, tp, ft)) return false;
        const size_t st = (size_t)256 * 2048 * 2; u.nt = 32;
        if (ft < 10) { u.A = H + tp * st; u.B = Wqkv + ft * st; u.pm = tp; u.pn = ft; u.kind = 0; }
        else { u.A = Wpq + (ft - 10) * st; u.B = H + tp * st; u.pm = ft - 10; u.pn = tp; u.kind = 1; }
        return true; }
};
struct SchedDft {
    const char* ADFT; const char* T; int G, c;
    __device__ __forceinline__ bool next(int i, Unit& u) const {
        int idx;
        if (G == 256) { if (i == 0 && c < 128) idx = c; else if (i == 1 && c < 8) idx = 128 + c; else return false; }
        else { const long L = (long)i * G + c; if (L >= 136) return false; idx = (int)L; }
        u.kind = 0;
        if (idx < 128) { const int b = idx >> 5, r = idx & 31, k1t = r >> 1, ct = r & 1;
            u.A = ADFT + (size_t)k1t * 256 * 8192 * 2; u.B = T + ((size_t)(b * 512 + ct * 256) * TLD + 512) * 2; u.nt = 128; u.pm = b * PPB + 1 + k1t; u.pn = 6 + ct; }
        else { const int cc = idx - 128, b = cc >> 1, ct = cc & 1;
            u.A = ADFT + (size_t)4096 * 8192 * 2; u.B = T + ((size_t)(b * 512 + ct * 256) * TLD) * 2; u.nt = 8; u.pm = b * PPB; u.pn = 6 + ct; }
        return true; }
};
struct SchedRkvl {
    const char* MIXES; const char* W; const char* L1; int G, c;
    __device__ __forceinline__ bool next(int i, Unit& u) const {
        int tp, ft; if (!tile_of((long)i * G + c, NPAN, 28, tp, ft)) return false;
        const size_t st = (size_t)256 * 2048 * 2; u.nt = 32; u.pm = tp;
        int mix;
        if (ft < 24) { const int which = ft >> 3; mix = (which == 0) ? 0 : (which == 1 ? 2 : 3); u.B = W + (size_t)which * 8 * MiB + (size_t)(ft & 7) * st; u.pn = ft & 7; u.kind = which; }
        else { const int q = ft - 24; mix = (q == 0) ? 1 : (q == 1 ? 4 : (q == 2 ? 5 : 3)); u.B = L1 + (size_t)q * st; u.pn = q; u.kind = 3; }
        u.A = MIXES + (size_t)mix * MIXSZ + tp * st;
        return true; }
};
struct SchedLora2 {
    const char* L; const char* W2; int nN, G, c;
    __device__ __forceinline__ bool next(int i, Unit& u) const {
        int tp, ft; if (!tile_of((long)i * G + c, NPAN, nN, tp, ft)) return false;
        const size_t bst = (size_t)256 * 256 * 2; u.nt = 4; u.pm = tp;
        int kind, pn; size_t wb;
        if (ft < 16) { kind = 0; pn = ft; wb = 0; } else if (ft < 32) { kind = 1; pn = ft - 16; wb = 2 * MiB; } else if (ft < 40) { kind = 2; pn = ft - 32; wb = 4 * MiB; } else { kind = 3; pn = ft - 40; wb = 5 * MiB; }
        u.A = L + (size_t)tp * 256 * 1024 * 2 + (size_t)kind * 512; u.B = W2 + wb + (size_t)pn * bst; u.pn = pn; u.kind = kind;
        if (kind != 2) { u.nt = 2; if (kind < 2 && pn >= 8) { u.A += 256; u.B += 256; } }
        return true; }
};

struct EpiStore {
    static constexpr bool PERM = true;
    bf16* O; int ldo;
    __device__ __forceinline__ void operator()(const f32x4 (&acc)[2][2][4][2], const Unit& u, int wr, int wc, int fr, int fq) const {
        const int row0 = u.pm * BM + wr * 64 + fr, col0 = u.pn * BM + wc * 32 + 8 * fq;
#pragma unroll
        for (int ai = 0; ai < 2; ++ai)
#pragma unroll
            for (int m = 0; m < 4; ++m) { bf16* rowp = O + (size_t)(row0 + ai * HALF + m * 16) * ldo + col0;
#pragma unroll
                for (int bj = 0; bj < 2; ++bj) { const f32x4 v0 = acc[ai][bj][m][0], v1 = acc[ai][bj][m][1];
                    u32x4 w; w.x = cvt_pk_bf16(v0[0], v0[1]); w.y = cvt_pk_bf16(v0[2], v0[3]); w.z = cvt_pk_bf16(v1[0], v1[1]); w.w = cvt_pk_bf16(v1[2], v1[3]);
                    *(u32x4*)(rowp + bj * HALF) = w; } }
    }
};
template <int CTRL> __device__ __forceinline__ f32x4 dpp4(const f32x4 x) { f32x4 r;
#pragma unroll
    for (int e = 0; e < 4; ++e) { const float xe = x[e]; r[e] = __int_as_float(__builtin_amdgcn_update_dpp(0, __float_as_int(xe), CTRL, 0xF, 0xF, true)); }
    return r; }
struct EpiUpConv {
    static constexpr bool PERM = false;
    bf16* ACT; bf16* HALO; const float* cw; const float* cb; LAS unsigned char* ex;
    __device__ __forceinline__ void operator()(const f32x4 (&acc)[2][2][4][2], const Unit& u, int wr, int wc, int fr, int fq) const {
        const int colb = wc * 32 + 4 * fq;
        LAS float* EX = (LAS float*)ex;
#pragma unroll
        for (int ai = 0; ai < 2; ++ai) { const int blk = 2 * ai + wr;
#pragma unroll
            for (int bj = 0; bj < 2; ++bj) {
                const bool top = (fr == 0);
                f32x4 e0, e1;
#pragma unroll
                for (int e = 0; e < 4; ++e) { e0[e] = top ? acc[ai][bj][0][0][e] : acc[ai][bj][3][0][e]; e1[e] = top ? acc[ai][bj][0][1][e] : acc[ai][bj][3][1][e]; }
                if (fr == 0 || fr == 15) { LAS float* p = EX + ((blk * 2 + (top ? 0 : 1)) * 256 + bj * HALF + colb); *(LAS f32x4*)p = e0; *(LAS f32x4*)(p + 16) = e1; }
            } }
        if (wr == 0 && fr < 2) {
#pragma unroll
            for (int bj = 0; bj < 2; ++bj) { const f32x4 v0 = acc[0][bj][0][0], v1 = acc[0][bj][0][1];
                u32x2 w0, w1; w0.x = cvt_pk_bf16(v0[0], v0[1]); w0.y = cvt_pk_bf16(v0[2], v0[3]); w1.x = cvt_pk_bf16(v1[0], v1[1]); w1.y = cvt_pk_bf16(v1[2], v1[3]);
                bf16* hp = HALO + ((size_t)u.pm * 4 + fr) * DFF2 + u.pn * 256 + bj * HALF + colb; *(u32x2*)hp = w0; *(u32x2*)(hp + 16) = w1; } }
        if (wr == 1 && fr >= 14) {
#pragma unroll
            for (int bj = 0; bj < 2; ++bj) { const f32x4 v0 = acc[1][bj][3][0], v1 = acc[1][bj][3][1];
                u32x2 w0, w1; w0.x = cvt_pk_bf16(v0[0], v0[1]); w0.y = cvt_pk_bf16(v0[2], v0[3]); w1.x = cvt_pk_bf16(v1[0], v1[1]); w1.y = cvt_pk_bf16(v1[2], v1[3]);
                bf16* hp = HALO + ((size_t)u.pm * 4 + (fr - 12)) * DFF2 + u.pn * 256 + bj * HALF + colb; *(u32x2*)hp = w0; *(u32x2*)(hp + 16) = w1; } }
        asm volatile("s_waitcnt lgkmcnt(0)" ::: "memory"); __builtin_amdgcn_s_barrier(); asm volatile("" ::: "memory");
        const int row0 = u.pm * BM + wr * 64 + fr;
#pragma unroll
        for (int n = 0; n < 2; ++n) {
            const int ch = u.pn * 128 + colb + 16 * n;
            const f32x4 wg0 = *(const f32x4*)(cw + ch), wg1 = *(const f32x4*)(cw + DFF2 + ch), wg2 = *(const f32x4*)(cw + 2 * DFF2 + ch), bg = *(const f32x4*)(cb + ch);
            const f32x4 wv0 = *(const f32x4*)(cw + DFF + ch), wv1 = *(const f32x4*)(cw + DFF2 + DFF + ch), wv2 = *(const f32x4*)(cw + 2 * DFF2 + DFF + ch), bv = *(const f32x4*)(cb + DFF + ch);
#pragma unroll
            for (int ai = 0; ai < 2; ++ai) { const int blk = 2 * ai + wr;
                const f32x4 z4 = (f32x4){0.f, 0.f, 0.f, 0.f};
                f32x4 xug = z4, xuv = z4, xdg = z4, xdv = z4;
                if (blk > 0) { xug = *(const LAS f32x4*)(EX + (((blk - 1) * 2 + 1) * 256 + colb + 16 * n)); xuv = *(const LAS f32x4*)(EX + (((blk - 1) * 2 + 1) * 256 + HALF + colb + 16 * n)); }
                if (blk < 3) { xdg = *(const LAS f32x4*)(EX + (((blk + 1) * 2 + 0) * 256 + colb + 16 * n)); xdv = *(const LAS f32x4*)(EX + (((blk + 1) * 2 + 0) * 256 + HALF + colb + 16 * n)); }
                u32x2 wm[4];
#pragma unroll
                for (int m = 0; m < 4; ++m) {
                    const f32x4 g = acc[ai][0][m][n], v = acc[ai][1][m][n];
                    const f32x4 gp = (m > 0) ? acc[ai][0][m > 0 ? m - 1 : 0][n] : xug, gn = (m < 3) ? acc[ai][0][m < 3 ? m + 1 : 3][n] : xdg;
                    const f32x4 vp = (m > 0) ? acc[ai][1][m > 0 ? m - 1 : 0][n] : xuv, vn = (m < 3) ? acc[ai][1][m < 3 ? m + 1 : 3][n] : xdv;
                    const f32x4 ug = dpp4<0x121>(fr == 15 ? gp : g), dg = dpp4<0x12F>(fr == 0 ? gn : g);
                    const f32x4 uv = dpp4<0x121>(fr == 15 ? vp : v), dv = dpp4<0x12F>(fr == 0 ? vn : v);
                    const f32x4 pg = bg + wg0 * ug + wg1 * g + wg2 * dg, pv = bv + wv0 * uv + wv1 * v + wv2 * dv;
                    float o[4];
#pragma unroll
                    for (int e = 0; e < 4; ++e) o[e] = pg[e] * sigmoidf_(pg[e]) * pv[e];
                    wm[m].x = cvt_pk_bf16(o[0], o[1]); wm[m].y = cvt_pk_bf16(o[2], o[3]);
                    if (m & 1) {
                        const auto rx = __builtin_amdgcn_permlane16_swap(wm[m - 1].x, wm[m].x, false, false), ry = __builtin_amdgcn_permlane16_swap(wm[m - 1].y, wm[m].y, false, false);
                        u32x4 w4; w4.x = rx[0]; w4.y = ry[0]; w4.z = rx[1]; w4.w = ry[1];
                        *(u32x4*)(ACT + (size_t)(row0 + ai * HALF + (m - 1 + (fq & 1)) * 16) * DFF + ch - 4 * (fq & 1)) = w4; }
                } }
        }
    }
};
struct EpiInproj {
    static constexpr bool PERM = true;
    bf16* QKV; bf16* T; const float* qg; const float* kg; const float* RC; const float* RS; LAS unsigned char* ex;
    __device__ __forceinline__ void operator()(const f32x4 (&acc)[2][2][4][2], const Unit& u, int wr, int wc, int fr, int fq) const {
        if (u.kind == 0) {
            if (u.pn >= 8) { EpiStore e{QKV, NQKV}; e(acc, u, wr, wc, fr, fq); return; }
            LAS float* EX = (LAS float*)ex;
            const float* gain = (u.pn < 6) ? qg : kg;
            const int b = u.pm / PPB, tile = u.pm % PPB, colb = wc * 32 + 8 * fq;
#pragma unroll
            for (int ai = 0; ai < 2; ++ai)
#pragma unroll
                for (int m = 0; m < 4; ++m)
#pragma unroll
                    for (int bj = 0; bj < 2; ++bj) { const f32x4 v0 = acc[ai][bj][m][0], v1 = acc[ai][bj][m][1];
                        float ss = (v0[0] * v0[0] + v0[1] * v0[1]) + (v0[2] * v0[2] + v0[3] * v0[3]) + (v1[0] * v1[0] + v1[1] * v1[1]) + (v1[2] * v1[2] + v1[3] * v1[3]);
                        ss += __shfl_xor(ss, 16); ss += __shfl_xor(ss, 32);
                        if (fq == 0) EX[((ai * HALF + wr * 64 + m * 16 + fr) * 2 + bj) * 4 + wc] = ss; }
            asm volatile("s_waitcnt lgkmcnt(0)" ::: "memory"); __builtin_amdgcn_s_barrier(); asm volatile("" ::: "memory");
            const int row0 = u.pm * BM + wr * 64 + fr;
#pragma unroll
            for (int bj = 0; bj < 2; ++bj) {
                const f32x4 g0 = *(const f32x4*)(gain + colb), g1 = *(const f32x4*)(gain + colb + 4);
#pragma unroll
                for (int ai = 0; ai < 2; ++ai)
#pragma unroll
                    for (int m = 0; m < 4; ++m) { const int rl = ai * HALF + wr * 64 + m * 16 + fr;
                        const f32x4 p4 = *(const LAS f32x4*)(EX + (rl * 2 + bj) * 4);
                        const float rstd = rsqrtf(((p4[0] + p4[1]) + (p4[2] + p4[3])) * (1.0f / 128.0f) + 1e-6f);
                        float x[8];
#pragma unroll
                        for (int e = 0; e < 4; ++e) { x[e] = acc[ai][bj][m][0][e] * rstd * g0[e]; x[4 + e] = acc[ai][bj][m][1][e] * rstd * g1[e]; }
                        if (tile != 0) { const int t = (tile - 1) * 256 + rl;
                            const f32x4 cc = *(const f32x4*)(RC + (size_t)t * 64 + (colb >> 1)), sn = *(const f32x4*)(RS + (size_t)t * 64 + (colb >> 1));
#pragma unroll
                            for (int p = 0; p < 4; ++p) { const float x0 = x[2 * p], x1 = x[2 * p + 1]; x[2 * p] = x0 * cc[p] - x1 * sn[p]; x[2 * p + 1] = x0 * sn[p] + x1 * cc[p]; } }
                        u32x4 w; w.x = cvt_pk_bf16(x[0], x[1]); w.y = cvt_pk_bf16(x[2], x[3]); w.z = cvt_pk_bf16(x[4], x[5]); w.w = cvt_pk_bf16(x[6], x[7]);
                        *(u32x4*)(QKV + (size_t)(row0 + ai * HALF + m * 16) * NQKV + u.pn * BM + bj * HALF + colb) = w; }
            }
            (void)b;
            return; }
        const int b = u.pn / PPB, tile = u.pn % PPB;
        const int j0 = u.pm * BM + wr * 64 + fr, cc0 = wc * 32 + 8 * fq;
#pragma unroll
        for (int ai = 0; ai < 2; ++ai)
#pragma unroll
            for (int m = 0; m < 4; ++m) { const int j = j0 + ai * HALF + m * 16, pq = j >> 9, gk = j & 511;
                const int off = (tile == 0) ? (pq * 256 + cc0) : (512 + pq * 4096 + (tile - 1) * 256 + cc0);
                bf16* rowp = T + (size_t)(b * 512 + gk) * TLD + off;
#pragma unroll
                for (int bj = 0; bj < 2; ++bj) { const f32x4 v0 = acc[ai][bj][m][0], v1 = acc[ai][bj][m][1];
                    u32x4 w; w.x = cvt_pk_bf16(v0[0], v0[1]); w.y = cvt_pk_bf16(v0[2], v0[3]); w.z = cvt_pk_bf16(v1[0], v1[1]); w.w = cvt_pk_bf16(v1[2], v1[3]);
                    *(u32x4*)(rowp + bj * HALF) = w; } }
    }
};
struct EpiResid {
    static constexpr bool PERM = true;
    bf16* X; const float* gate; unsigned short* PART;
    __device__ __forceinline__ void operator()(const f32x4 (&acc)[2][2][4][2], const Unit& u, int wr, int wc, int fr, int fq) const {
        const int b = u.pm / PPB, tile = u.pm % PPB, rc = (tile == 0) ? 4 : b;
        const int row0 = u.pm * BM + wr * 64 + fr, col0 = u.pn * BM + wc * 32 + 8 * fq;
        if (u.kind > 0) {
            unsigned short* pb = PART + ((size_t)(u.kind - 1) * 1024 + (size_t)b * 256 + wr * 64 + fr) * DM + col0;
#pragma unroll
            for (int ai = 0; ai < 2; ++ai)
#pragma unroll
                for (int m = 0; m < 4; ++m)
#pragma unroll
                    for (int bj = 0; bj < 2; ++bj) { const f32x4 v0 = acc[ai][bj][m][0], v1 = acc[ai][bj][m][1];
                        u32x4 w; w.x = pk2h(v0[0], v0[1]); w.y = pk2h(v0[2], v0[3]); w.z = pk2h(v1[0], v1[1]); w.w = pk2h(v1[2], v1[3]);
                        *(u32x4*)(pb + (size_t)(ai * HALF + m * 16) * DM + bj * HALF) = w; }
            return; }
        const float* gp = gate + (size_t)rc * 12288 + col0;
        f32x4 gv[2][2];
#pragma unroll
        for (int bj = 0; bj < 2; ++bj)
#pragma unroll
            for (int n = 0; n < 2; ++n) gv[bj][n] = *(const f32x4*)(gp + bj * HALF + n * 4);
        u32x4 xv[2][4][2];
#pragma unroll
        for (int ai = 0; ai < 2; ++ai)
#pragma unroll
            for (int m = 0; m < 4; ++m)
#pragma unroll
                for (int bj = 0; bj < 2; ++bj) xv[ai][m][bj] = *(const u32x4*)(X + (size_t)(row0 + ai * HALF + m * 16) * DM + col0 + bj * HALF);
#pragma unroll
        for (int ai = 0; ai < 2; ++ai)
#pragma unroll
            for (int m = 0; m < 4; ++m)
#pragma unroll
                for (int bj = 0; bj < 2; ++bj) { const u32x4 x4 = xv[ai][m][bj];
                    const f32x4 a0 = gv[bj][0] * acc[ai][bj][m][0], a1 = gv[bj][1] * acc[ai][bj][m][1];
                    u32x4 w; w.x = pk2h(hlo(x4.x) + a0[0], hhi(x4.x) + a0[1]); w.y = pk2h(hlo(x4.y) + a0[2], hhi(x4.y) + a0[3]);
                    w.z = pk2h(hlo(x4.z) + a1[0], hhi(x4.z) + a1[1]); w.w = pk2h(hlo(x4.w) + a1[2], hhi(x4.w) + a1[3]);
                    *(u32x4*)(X + (size_t)(row0 + ai * HALF + m * 16) * DM + col0 + bj * HALF) = w; }
    }
};
struct EpiRkvl {
    static constexpr bool PERM = true;
    bf16* R; bf16* K; bf16* V; bf16* L;
    __device__ __forceinline__ void operator()(const f32x4 (&acc)[2][2][4][2], const Unit& u, int wr, int wc, int fr, int fq) const {
        if (u.kind < 3) { EpiStore e{u.kind == 0 ? R : (u.kind == 1 ? K : V), DM}; e(acc, u, wr, wc, fr, fq); return; }
        const int row0 = u.pm * BM + wr * 64 + fr, col0 = u.pn * BM + wc * 32 + 8 * fq, act = u.pn;
#pragma unroll
        for (int ai = 0; ai < 2; ++ai)
#pragma unroll
            for (int m = 0; m < 4; ++m) { bf16* rowp = L + (size_t)(row0 + ai * HALF + m * 16) * 1024 + col0;
#pragma unroll
                for (int bj = 0; bj < 2; ++bj) { float v[8];
#pragma unroll
                    for (int e = 0; e < 4; ++e) { v[e] = acc[ai][bj][m][0][e]; v[4 + e] = acc[ai][bj][m][1][e]; }
                    if (act == 0) {
#pragma unroll
                        for (int e = 0; e < 8; ++e) v[e] = tanhf_(v[e]);
                    } else if (act == 2) {
#pragma unroll
                        for (int e = 0; e < 8; ++e) v[e] = sigmoidf_(v[e]);
                    }
                    u32x4 w; w.x = cvt_pk_bf16(v[0], v[1]); w.y = cvt_pk_bf16(v[2], v[3]); w.z = cvt_pk_bf16(v[4], v[5]); w.w = cvt_pk_bf16(v[6], v[7]);
                    *(u32x4*)(rowp + bj * HALF) = w; } }
    }
};
struct EpiLora2 {
    static constexpr bool PERM = true;
    unsigned short* E; unsigned short* AA; bf16* Gg; bf16* V; const bf16* VF; const float* w0; const float* a0; const float* v0;
    __device__ __forceinline__ void operator()(const f32x4 (&acc)[2][2][4][2], const Unit& u, int wr, int wc, int fr, int fq) const {
        const int row0 = u.pm * BM + wr * 64 + fr, col0 = u.pn * BM + wc * 32 + 8 * fq, kind = u.kind;
        float bias[2][8];
#pragma unroll
        for (int bj = 0; bj < 2; ++bj)
#pragma unroll
            for (int e = 0; e < 8; ++e) { const int c = col0 + bj * HALF + e; bias[bj][e] = (kind == 0) ? w0[c] : (kind == 1 ? a0[c] : (kind == 3 ? v0[c] : 0.f)); }
#pragma unroll
        for (int ai = 0; ai < 2; ++ai)
#pragma unroll
            for (int m = 0; m < 4; ++m) { const size_t row = (size_t)(row0 + ai * HALF + m * 16);
#pragma unroll
                for (int bj = 0; bj < 2; ++bj) { float v[8];
#pragma unroll
                    for (int e = 0; e < 4; ++e) { v[e] = acc[ai][bj][m][0][e] + bias[bj][e]; v[4 + e] = acc[ai][bj][m][1][e] + bias[bj][4 + e]; }
                    const int c = col0 + bj * HALF;
                    if (kind == 0 || kind == 1) {
                        const float isc = (kind == 0) ? 1.6487212707f : 1.0f;
                        u32x4 w; unsigned short hh[8];
#pragma unroll
                        for (int e = 0; e < 8; ++e) hh[e] = f2h(__builtin_amdgcn_rcpf(fmaf(__builtin_amdgcn_exp2f(v[e] * -1.4426950408889634f), isc, isc)));
                        w.x = hh[0] | ((unsigned)hh[1] << 16); w.y = hh[2] | ((unsigned)hh[3] << 16); w.z = hh[4] | ((unsigned)hh[5] << 16); w.w = hh[6] | ((unsigned)hh[7] << 16);
                        *(u32x4*)((kind == 0 ? E : AA) + row * 4096 + c) = w;
                    } else if (kind == 2) {
                        u32x4 w; w.x = cvt_pk_bf16(v[0], v[1]); w.y = cvt_pk_bf16(v[2], v[3]); w.z = cvt_pk_bf16(v[4], v[5]); w.w = cvt_pk_bf16(v[6], v[7]);
                        *(u32x4*)(Gg + row * DM + c) = w;
                    } else {
                        const u32x4 vv = *(const u32x4*)(V + row * DM + c), vf = *(const u32x4*)(VF + row * DM + c);
                        float o[8];
#pragma unroll
                        for (int q = 0; q < 4; ++q) { const float a0_ = bflo(vv[q]), a1_ = bfhi(vv[q]), f0 = bflo(vf[q]), f1 = bfhi(vf[q]);
                            o[2 * q] = a0_ + (f0 - a0_) * sigmoidf_(v[2 * q]); o[2 * q + 1] = a1_ + (f1 - a1_) * sigmoidf_(v[2 * q + 1]); }
                        u32x4 w; w.x = cvt_pk_bf16(o[0], o[1]); w.y = cvt_pk_bf16(o[2], o[3]); w.z = cvt_pk_bf16(o[4], o[5]); w.w = cvt_pk_bf16(o[6], o[7]);
                        *(u32x4*)(V + row * DM + c) = w;
                    } } }
    }
};
}

namespace att {
constexpr int D = 128, NW = 8, QBLK = 32, KVBLK = 64;
constexpr float SCALE = 0.088388347648318440f;
constexpr float THR = 8.f;
constexpr int LDQ = NQKV, LDK = NQKV, LDO = DM;
constexpr size_t SHM_V = KVBLK * D * 2, SHM_K = KVBLK * D * 2, SHM_ATTN = 2 * SHM_V + 2 * SHM_K + NW * 64 * 4;
#define KSWZ(row, colB) ((row) * 256 + ((colB) ^ (((row) & 7) << 4)))
#define SBAR() __builtin_amdgcn_sched_barrier(0)
__device__ __forceinline__ int crow(int r, int hi) { return (r & 3) + 8 * (r >> 2) + 4 * hi; }
__device__ __forceinline__ unsigned cvtpk(float lo, float hi) { unsigned r; asm volatile("v_cvt_pk_bf16_f32 %0, %1, %2" : "=v"(r) : "v"(lo), "v"(hi)); return r; }
__device__ __forceinline__ void partialSM(f32x16& p0, f32x16& p1, float& m_reg, float& mn, float& alpha) {
  constexpr float C = SCALE * 1.4426950408889634f;
  float pmax = p0[0]; for (int r = 1; r < 16; ++r) pmax = fmaxf(pmax, p0[r]); for (int r = 0; r < 16; ++r) pmax = fmaxf(pmax, p1[r]);
  { auto rr = __builtin_amdgcn_permlane32_swap(__float_as_uint(pmax), __float_as_uint(pmax), false, false);
    pmax = fmaxf(__uint_as_float(rr[0]), __uint_as_float(rr[1])); }
  if (__builtin_expect(__all(pmax - m_reg <= THR / SCALE), 1)) { mn = m_reg; alpha = 1.f; }
  else { mn = fmaxf(m_reg, pmax); alpha = __builtin_amdgcn_exp2f((m_reg - mn) * C); m_reg = mn; }
  float mnC = -mn * C;
  { const f32x2_cv C2 = {C, C}, M2 = {mnC, mnC};
    for (int r = 0; r < 8; ++r) { f32x2_cv t = {p0[2 * r], p0[2 * r + 1]}; t = t * C2 + M2; p0[2 * r] = t[0]; p0[2 * r + 1] = t[1]; }
    for (int r = 0; r < 8; ++r) { f32x2_cv t = {p1[2 * r], p1[2 * r + 1]}; t = t * C2 + M2; p1[2 * r] = t[0]; p1[2 * r + 1] = t[1]; } }
  for (int r = 0; r < 16; ++r) p0[r] = __builtin_amdgcn_exp2f(p0[r]);
}
__device__ __forceinline__ void finishSM(f32x16& p0, f32x16& p1, float alpha, float& l_reg, bf16x8& pa0, bf16x8& pa1, bf16x8& pa2, bf16x8& pa3) {
  for (int r = 0; r < 16; ++r) p1[r] = __builtin_amdgcn_exp2f(p1[r]);
  float ps;
  { f32x2_cv s2 = {0.f, 0.f}, s3 = {0.f, 0.f};
    for (int r = 0; r < 8; ++r) { s2 += (f32x2_cv){p0[2 * r], p0[2 * r + 1]}; s3 += (f32x2_cv){p1[2 * r], p1[2 * r + 1]}; }
    s2 += s3; ps = s2[0] + s2[1]; }
  { auto rr = __builtin_amdgcn_permlane32_swap(__float_as_uint(ps), __float_as_uint(ps), false, false);
    ps = __uint_as_float(rr[0]) + __uint_as_float(rr[1]); }
  l_reg = l_reg * alpha + ps;
#define PK4(P, BASE, OUT) do { unsigned a0 = cvtpk(P[BASE + 0], P[BASE + 1]), a1 = cvtpk(P[BASE + 2], P[BASE + 3]);   \
    unsigned b0 = cvtpk(P[BASE + 4], P[BASE + 5]), b1 = cvtpk(P[BASE + 6], P[BASE + 7]);                              \
    auto r0 = __builtin_amdgcn_permlane32_swap(a0, b0, false, false); auto r1 = __builtin_amdgcn_permlane32_swap(a1, b1, false, false); \
    u32x4 w = {r0[0], r1[0], r0[1], r1[1]}; OUT = *reinterpret_cast<bf16x8*>(&w); } while (0)
  PK4(p0, 0, pa0); PK4(p0, 8, pa1); PK4(p1, 0, pa2); PK4(p1, 8, pa3);
#undef PK4
}
__device__ __forceinline__ void qkt(f32x16& p0, f32x16& p1, const bf16* Ks, const bf16x8* qr, int r32, int hi) {
  p0 = f32x16{}; p1 = f32x16{};
  for (int d0 = 0; d0 < 8; ++d0) { int cb = (d0 * 16 + hi * 8) * 2;
    bf16x8 b0 = *reinterpret_cast<const bf16x8*>((const char*)Ks + KSWZ(r32, cb));
    bf16x8 b1 = *reinterpret_cast<const bf16x8*>((const char*)Ks + KSWZ(32 + r32, cb));
    p0 = __builtin_amdgcn_mfma_f32_32x32x16_bf16(b0, qr[d0], p0, 0, 0, 0);
    p1 = __builtin_amdgcn_mfma_f32_32x32x16_bf16(b1, qr[d0], p1, 0, 0, 0); }
}
__device__ __forceinline__ int v_st(int k, int c) { const int kk = (k & ~0xC) | ((k & 4) << 1) | ((k & 8) >> 1); return ((kk >> 3) * 4 + (c >> 5)) * 512 + ((kk & 7) * 32 + (c & 31)) * 2; }
__device__ __forceinline__ int v_rd_base(int lane) { return ((lane & 3) << 3) | (((lane >> 2) & 3) << 6) | (((lane >> 4) & 1) << 5) | (((lane >> 5) & 1) << 8); }
constexpr int v_rd_off(int d0, int ks, int half) { return d0 * 512 + ks * 4096 + half * 2048; }
template <int OFF> __device__ __forceinline__ s16x4 tr_read(int vb) {
  s16x4 r; asm volatile("ds_read_b64_tr_b16 %0, %1 offset:%2" : "=&v"(r) : "v"(vb), "i"(OFF) : "memory"); return r;
}
template <int D0> __device__ __forceinline__ void pv_one(f32x16& od, int vb, bf16x8 pa0, bf16x8 pa1, bf16x8 pa2, bf16x8 pa3) {
  const s16x4 l0 = tr_read<v_rd_off(D0, 0, 0)>(vb), h0 = tr_read<v_rd_off(D0, 0, 1)>(vb), l1 = tr_read<v_rd_off(D0, 1, 0)>(vb), h1 = tr_read<v_rd_off(D0, 1, 1)>(vb);
  const s16x4 l2 = tr_read<v_rd_off(D0, 2, 0)>(vb), h2 = tr_read<v_rd_off(D0, 2, 1)>(vb), l3 = tr_read<v_rd_off(D0, 3, 0)>(vb), h3 = tr_read<v_rd_off(D0, 3, 1)>(vb);
  asm volatile("s_waitcnt lgkmcnt(0)" ::: "memory"); SBAR();
#define PK(L, H) (bf16x8){L[0], L[1], L[2], L[3], H[0], H[1], H[2], H[3]}
  od = __builtin_amdgcn_mfma_f32_32x32x16_bf16(pa0, PK(l0, h0), od, 0, 0, 0);
  od = __builtin_amdgcn_mfma_f32_32x32x16_bf16(pa1, PK(l1, h1), od, 0, 0, 0);
  od = __builtin_amdgcn_mfma_f32_32x32x16_bf16(pa2, PK(l2, h2), od, 0, 0, 0);
  od = __builtin_amdgcn_mfma_f32_32x32x16_bf16(pa3, PK(l3, h3), od, 0, 0, 0);
#undef PK
}
__device__ __forceinline__ void pv_d0(f32x16* o, int vb, bf16x8 pa0, bf16x8 pa1, bf16x8 pa2, bf16x8 pa3) {
  pv_one<0>(o[0], vb, pa0, pa1, pa2, pa3); pv_one<1>(o[1], vb, pa0, pa1, pa2, pa3); pv_one<2>(o[2], vb, pa0, pa1, pa2, pa3); pv_one<3>(o[3], vb, pa0, pa1, pa2, pa3);
}
__device__ __forceinline__ void attn_unit(const bf16* __restrict__ Qb, const bf16* __restrict__ Kh, const bf16* __restrict__ Vh, bf16* __restrict__ Ob, int seq,
                                          const float* __restrict__ qg, const float* __restrict__ rc, const float* __restrict__ rs, char* lds, int wave_) {
  const int tid = opaque_tid(wave_), wid = tid >> 6, lane = tid & 63, r32 = lane & 31, hi = lane >> 5;
  bf16* V_lds = (bf16*)lds; bf16* K_lds = (bf16*)(lds + 2 * SHM_V);
  float* ws = (float*)(lds + 2 * SHM_V + 2 * SHM_K) + wid * 64; float* li_l = ws; float* al_l = ws + 32;
  float m_reg = -1e30f, l_reg = 0; f32x16 o[4] = {}; bf16x8 qr[8];
  {
    const bf16* Qw = Qb + (long)(wid * QBLK + r32) * LDQ + hi * 8;
#pragma unroll
    for (int d0 = 0; d0 < 8; ++d0) qr[d0] = *reinterpret_cast<const bf16x8*>(Qw + d0 * 16);
  }
  const int sr = tid >> 4, sc = (tid & 15) * 8, vst0 = v_st(sr, sc), vst1 = v_st(32 + sr, sc);
  const int vb0 = (int)(uintptr_t)V_lds + v_rd_base(lane);
  struct { bf16x8 vs0, vs1, ks0, ks1; } sr_[2];
#define SLOAD(i, k0) do { sr_[i].vs0 = *reinterpret_cast<const bf16x8*>(&Vh[(long)((k0) + sr) * LDK + sc]); sr_[i].vs1 = *reinterpret_cast<const bf16x8*>(&Vh[(long)((k0) + 32 + sr) * LDK + sc]); \
    sr_[i].ks0 = *reinterpret_cast<const bf16x8*>(&Kh[(long)((k0) + sr) * LDK + sc]); sr_[i].ks1 = *reinterpret_cast<const bf16x8*>(&Kh[(long)((k0) + 32 + sr) * LDK + sc]); } while (0)
#define SWRITE(b, i) do { *(bf16x8*)((char*)V_lds + (b) * SHM_V + vst0) = sr_[i].vs0;          \
    *(bf16x8*)((char*)V_lds + (b) * SHM_V + vst1) = sr_[i].vs1; int kc = sc * 2;               \
    *(bf16x8*)((char*)K_lds + (b) * SHM_K + KSWZ(sr, kc)) = sr_[i].ks0;                       \
    *(bf16x8*)((char*)K_lds + (b) * SHM_K + KSWZ(32 + sr, kc)) = sr_[i].ks1; } while (0)
#define SWAIT() asm volatile("s_waitcnt vmcnt(4)" ::: "memory")
#define RESC(a) do { if (__any((a) < 1.f)) { if (hi == 0) al_l[r32] = (a); asm volatile("s_waitcnt lgkmcnt(0)" ::: "memory"); \
    for (int d = 0; d < 4; ++d) for (int r = 0; r < 16; ++r) o[d][r] *= al_l[crow(r, hi)]; } } while (0)
  f32x16 pA0, pA1, pB0, pB1; float mnA, mnB, alA, alB; bf16x8 pa0, pa1, pa2, pa3; const int NTL = seq / KVBLK;
  constexpr int SE = 0, SO = 1;
  SLOAD(SE, 0); asm volatile("s_waitcnt vmcnt(0)" ::: "memory"); SWRITE(0, SE); __syncthreads();
  qkt(pA0, pA1, K_lds, qr, r32, hi); partialSM(pA0, pA1, m_reg, mnA, alA);
  SLOAD(SO, KVBLK); if (2 < NTL) SLOAD(SE, 2 * KVBLK);
  SWAIT(); SWRITE(1, SO); __syncthreads();
  for (int j = 1; j + 1 < NTL; j += 2) {
    SBAR(); qkt(pB0, pB1, (bf16*)((char*)K_lds + SHM_K), qr, r32, hi);
    finishSM(pA0, pA1, alA, l_reg, pa0, pa1, pa2, pa3); SBAR();
    SLOAD(SO, (j + 2) * KVBLK); SBAR();
    pv_d0(o, vb0, pa0, pa1, pa2, pa3); partialSM(pB0, pB1, m_reg, mnB, alB);
    __syncthreads(); SWAIT(); SWRITE(0, SE);
    RESC(alB); __syncthreads();
    SBAR(); qkt(pA0, pA1, K_lds, qr, r32, hi);
    finishSM(pB0, pB1, alB, l_reg, pa0, pa1, pa2, pa3); SBAR();
    if (j + 3 < NTL) SLOAD(SE, (j + 3) * KVBLK); SBAR();
    pv_d0(o, vb0 + (int)SHM_V, pa0, pa1, pa2, pa3); partialSM(pA0, pA1, m_reg, mnA, alA);
    __syncthreads(); SWAIT(); SWRITE(1, SO);
    RESC(alA); __syncthreads();
  }
  SBAR(); qkt(pB0, pB1, (bf16*)((char*)K_lds + SHM_K), qr, r32, hi);
  finishSM(pA0, pA1, alA, l_reg, pa0, pa1, pa2, pa3); SBAR();
  pv_d0(o, vb0, pa0, pa1, pa2, pa3); partialSM(pB0, pB1, m_reg, mnB, alB);
  __syncthreads(); RESC(alB);
  finishSM(pB0, pB1, alB, l_reg, pa0, pa1, pa2, pa3); SBAR();
  pv_d0(o, vb0 + (int)SHM_V, pa0, pa1, pa2, pa3);
  if (hi == 0) li_l[r32] = l_reg; asm volatile("s_waitcnt lgkmcnt(0)" ::: "memory");
  float rli[16];
#pragma unroll
  for (int r = 0; r < 16; ++r) rli[r] = __builtin_amdgcn_rcpf(li_l[crow(r, hi)]);
  __syncthreads();
  {
    constexpr int SP = 272;
    LAS unsigned char* stg = (LAS unsigned char*)lds + wid * (32 * SP);
#pragma unroll
    for (int r = 0; r < 16; ++r) { LAS unsigned char* p = stg + crow(r, hi) * SP + r32 * 2;
#pragma unroll
      for (int d0 = 0; d0 < 4; d0 += 2) { const unsigned pk = cvt_pk_bf16(o[d0][r] * rli[r], o[d0 + 1][r] * rli[r]);
        *(LAS unsigned short*)(p + d0 * 64) = (unsigned short)pk; *(LAS unsigned short*)(p + (d0 + 1) * 64) = (unsigned short)(pk >> 16); } }
    asm volatile("s_waitcnt lgkmcnt(0)" ::: "memory");
    bf16* Ow = Ob + (long)(wid * QBLK) * LDO;
#pragma unroll
    for (int j = 0; j < 8; ++j) { const int row = 4 * j + (lane >> 4), ck = lane & 15;
      const u32x4 w = *(const LAS u32x4*)(stg + row * SP + ck * 16);
      *(u32x4*)(Ow + (long)row * LDO + ck * 8) = w; }
  }
#undef SLOAD
#undef SWRITE
#undef SWAIT
#undef RESC
}
}

struct Args { const float* in[38]; float* out; unsigned char* ws; };
enum { I_X = 0, I_C, I_CTX, I_CCTX, I_WMOD, I_BMOD, I_N1G, I_N2G, I_AWIN, I_AWOUT, I_QG, I_KG, I_MU, I_WR, I_WK, I_WV, I_WO, I_DW0, I_DW1, I_DW2, I_IA0, I_IA1, I_IA2,
       I_GG1, I_GG2, I_KK, I_KA, I_RK, I_LNG, I_LNB, I_V0, I_V1, I_V2, I_WUP, I_CW, I_CB, I_WDN, I_FNG };

struct Frame {
    LAS unsigned char* lds; char* ldsg;
    int vcu, G, NGW, wave;
    unsigned char* ws;
};
constexpr int EX_OFF = RING_BYTES + 2048;
constexpr int PTAB_OFF = RING_BYTES + 1024;
__device__ __forceinline__ const float* in_ptr(const Frame& F, int i) {
    const LAS unsigned* p = (const LAS unsigned*)(F.lds + opaque_s(PTAB_OFF + 8 * i));
    const unsigned lo = (unsigned)__builtin_amdgcn_readfirstlane((int)p[0]), hi = (unsigned)__builtin_amdgcn_readfirstlane((int)p[1]);
    return (const float*)(((unsigned long long)hi << 32) | lo);
}
#define PHASE_IDS() const int wave = opaque_s(F.wave), tid = opaque_tid(wave), lane = tid & 63, gw = F.vcu * 8 + wave, NGW = F.NGW; (void)lane; (void)gw; (void)NGW

__device__ __forceinline__ void transpose_item(const float* W, int ldw, int coloff, int N, bf16* WT, int ldt, int row_off, LAS float* scr, int item, int lane, bool perm_up = false) {
    const int nblk = N / 32, kb = item / nblk, nb = item % nblk, k0 = 64 * kb, n0 = 32 * nb;
    if (perm_up) row_off = ((n0 % DFF) / 128) * 256 + (n0 / DFF) * 128 + (n0 % 128) - n0;
    const int r8 = lane >> 3, c4 = (lane & 7) * 4;
    f32x4 v[8];
#pragma unroll
    for (int i = 0; i < 8; ++i) v[i] = __builtin_nontemporal_load((const f32x4*)(W + (size_t)(k0 + i * 8 + r8) * ldw + coloff + n0 + c4));
#pragma unroll
    for (int i = 0; i < 8; ++i) { LAS float* d = scr + (i * 8 + r8) * 33 + c4; d[0] = v[i][0]; d[1] = v[i][1]; d[2] = v[i][2]; d[3] = v[i][3]; }
    LDS_WAIT(); asm volatile("" ::: "memory");
    const int c = lane & 7;
#pragma unroll
    for (int j = 0; j < 4; ++j) { const int n = (lane >> 3) + 8 * j; const LAS float* s = scr + (8 * c) * 33 + n;
        u32x4 o; o.x = pk2(s[0 * 33], s[1 * 33]); o.y = pk2(s[2 * 33], s[3 * 33]); o.z = pk2(s[4 * 33], s[5 * 33]); o.w = pk2(s[6 * 33], s[7 * 33]);
        *(u32x4*)(WT + (size_t)(row_off + n0 + n) * ldt + k0 + 8 * c) = o; }
    LDS_WAIT(); asm volatile("" ::: "memory");
}
__device__ __forceinline__ void transpose_item32(const float* W, int ldw, int N, bf16* WT, int ldt, int row_off, int col_off, LAS float* scr, int item, int lane) {
    const int nblk = N / 32, kb = item / nblk, nb = item % nblk, k0 = 32 * kb, n0 = 32 * nb;
    const int r8 = lane >> 3, c4 = (lane & 7) * 4;
    f32x4 v[4];
#pragma unroll
    for (int i = 0; i < 4; ++i) v[i] = __builtin_nontemporal_load((const f32x4*)(W + (size_t)(k0 + i * 8 + r8) * ldw + n0 + c4));
#pragma unroll
    for (int i = 0; i < 4; ++i) { LAS float* d = scr + (i * 8 + r8) * 33 + c4; d[0] = v[i][0]; d[1] = v[i][1]; d[2] = v[i][2]; d[3] = v[i][3]; }
    LDS_WAIT(); asm volatile("" ::: "memory");
    const int c = lane & 3;
#pragma unroll
    for (int j = 0; j < 2; ++j) { const int n = (lane >> 2) + 16 * j; const LAS float* s = scr + (8 * c) * 33 + n;
        u32x4 o; o.x = pk2(s[0 * 33], s[1 * 33]); o.y = pk2(s[2 * 33], s[3 * 33]); o.z = pk2(s[4 * 33], s[5 * 33]); o.w = pk2(s[6 * 33], s[7 * 33]);
        *(u32x4*)(WT + (size_t)(row_off + n0 + n) * ldt + col_off + k0 + 8 * c) = o; }
    LDS_WAIT(); asm volatile("" ::: "memory");
}

__device__ __forceinline__ void p0_prologue(const Frame& F) {
    PHASE_IDS();
    LAS float* scr = (LAS float*)(F.lds + wave * 16384);
    unsigned char* ws = F.ws;
    {
        constexpr int P_UP = 32 * 352, P_DN = 88 * 64, P_QKV = 32 * 80, P_SQ = 32 * 64;
        constexpr int NITEMS = 4 * P_UP + 4 * P_DN + 2 * P_QKV + 2 * P_SQ + 8 * P_SQ;
        const bool defer = (F.G == 256);
        for (int it = gw; it < NITEMS; it += NGW) {
            int r = it;
            if (r < 4 * P_UP) { const int l = r / P_UP; if (defer && l >= 2) continue; transpose_item(in_ptr(F, I_WUP) + (size_t)l * DM * DFF2, DFF2, 0, DFF2, (bf16*)(ws + WS_WUP) + (size_t)l * DFF2 * DM, DM, 0, scr, r % P_UP, lane, true); continue; } r -= 4 * P_UP;
            if (r < 4 * P_DN) { const int l = r / P_DN; if (defer && l >= 2) continue; transpose_item(in_ptr(F, I_WDN) + (size_t)l * DFF * DM, DM, 0, DM, (bf16*)(ws + WS_WDN) + (size_t)l * DM * DFF, DFF, 0, scr, r % P_DN, lane); continue; } r -= 4 * P_DN;
            if (r < 2 * P_QKV) { const int l = r / P_QKV; transpose_item(in_ptr(F, I_AWIN) + (size_t)l * DM * WIN, WIN, 0, NQKV, (bf16*)(ws + WS_WQKV) + (size_t)l * NQKV * DM, DM, 0, scr, r % P_QKV, lane); continue; } r -= 2 * P_QKV;
            if (r < 2 * P_SQ) { const int l = r / P_SQ; transpose_item(in_ptr(F, I_AWOUT) + (size_t)l * DM * DM, DM, 0, DM, (bf16*)(ws + WS_WOUT) + (size_t)l * DM * DM, DM, 0, scr, r % P_SQ, lane); continue; } r -= 2 * P_SQ;
            { const int mi = r / P_SQ, l = mi >> 2, which = mi & 3; if (defer) continue;
              const float* src = (which == 0 ? in_ptr(F, I_WR) : (which == 1 ? in_ptr(F, I_WK) : (which == 2 ? in_ptr(F, I_WV) : in_ptr(F, I_WO)))) + (size_t)l * DM * DM;
              transpose_item(src, DM, 0, DM, (bf16*)(ws + WS_WRKVO) + (size_t)mi * DM * DM, DM, 0, scr, r % P_SQ, lane); }
        }
    }
    {
        float* PART = (float*)(ws + WS_H);
        const float* cvec = in_ptr(F, I_C); const float* cctx = in_ptr(F, I_CCTX); const float* wmod = in_ptr(F, I_WMOD);
        for (int it = gw; it < 4 * 8 * 48; it += NGW) {
            const int i = it / 384, r = it % 384, kc = r / 48, nb = r % 48;
#pragma unroll
            for (int q = 0; q < 4; ++q) { const int kk = lane + 64 * q, k = kc * 256 + kk;
#pragma unroll
                for (int rc = 0; rc < 5; ++rc) { const float cv = (rc < 4) ? cvec[rc * DM + k] : cctx[k]; scr[rc * 256 + kk] = cv / (1.0f + __expf(-cv)); } }
            LDS_WAIT(); asm volatile("" ::: "memory");
            f32x4 acc[5];
#pragma unroll
            for (int rc = 0; rc < 5; ++rc) acc[rc] = (f32x4){0.f, 0.f, 0.f, 0.f};
            const float* wp = wmod + ((size_t)i * DM + (size_t)kc * 256) * 12288 + nb * 256 + lane * 4;
#pragma unroll 8
            for (int kk = 0; kk < 256; ++kk) { const f32x4 w4 = __builtin_nontemporal_load((const f32x4*)(wp + (size_t)kk * 12288));
#pragma unroll
                for (int rc = 0; rc < 5; ++rc) acc[rc] += scr[rc * 256 + kk] * w4; }
#pragma unroll
            for (int rc = 0; rc < 5; ++rc) *(f32x4*)(PART + ((size_t)(kc * 4 + i) * 5 + rc) * 12288 + nb * 256 + lane * 4) = acc[rc];
            LDS_WAIT(); asm volatile("" ::: "memory");
        }
    }
    const long gt = (long)F.vcu * 512 + tid, NGT = (long)F.G * 512;
    {
        float* RC = (float*)(ws + WS_ROPEC); float* RS = (float*)(ws + WS_ROPES);
        for (long idx = gt; idx < 4096 * 64; idx += NGT) { const int t = (int)(idx >> 6), i = (int)(idx & 63);
            const int pos = (i < 32) ? (t >> 6) : (t & 63); const float inv = powf(10000.0f, -(float)(2 * (i & 31)) / 64.0f);
            const float ang = (float)pos * inv; RC[idx] = cosf(ang); RS[idx] = sinf(ang); }
    }
    {
        bf16* AD = (bf16*)(ws + WS_ADFT);
        const float sL = 0.0013810679320049757f, sC = 0.005524271728019903f;
        for (long idx = gt; idx < (long)4096 * 1024; idx += NGT) { const int k1 = (int)(idx >> 10), cg = (int)(idx & 1023), n0 = (cg & 511) * 8; const bool isS = cg >= 512;
            float s0, c0, sd, cd; sincospif((float)((k1 * n0) & 4095) * (1.0f / 2048.0f), &s0, &c0); sincospif((float)k1 * (1.0f / 2048.0f), &sd, &cd);
            float v[8];
#pragma unroll
            for (int e = 0; e < 8; ++e) { v[e] = isS ? -s0 * sL : c0 * sL; const float c1 = c0 * cd - s0 * sd, s1 = s0 * cd + c0 * sd; c0 = c1; s0 = s1; }
            u32x4 w; w.x = pk2(v[0], v[1]); w.y = pk2(v[2], v[3]); w.z = pk2(v[4], v[5]); w.w = pk2(v[6], v[7]);
            *(u32x4*)(AD + (size_t)k1 * 8192 + cg * 8) = w; }
        for (long idx = gt; idx < (long)256 * 64; idx += NGT) { const int k1 = (int)(idx >> 6), cg = (int)(idx & 63), n0 = (cg & 31) * 8; const bool isS = cg >= 32;
            float v[8];
#pragma unroll
            for (int e = 0; e < 8; ++e) { const int mm = (k1 * (n0 + e)) & 255; float s, c; sincospif((float)mm * (1.0f / 128.0f), &s, &c); v[e] = isS ? -s * sC : c * sC; }
            u32x4 w; w.x = pk2(v[0], v[1]); w.y = pk2(v[2], v[3]); w.z = pk2(v[4], v[5]); w.w = pk2(v[6], v[7]);
            *(u32x4*)(AD + (size_t)(4096 + k1) * 8192 + cg * 8) = w; }
    }
    {
        LAS float* tab = scr + 1024;
        for (int q = 0; q < 4; ++q) { const int m = lane + 64 * q; float sn, cs; sincospif((float)(m & 127) * (1.0f / 64.0f), &sn, &cs); tab[m] = (m < 128) ? cs : sn; }
        for (int it = gw; it < 2048; it += NGW) {
            const int ko = it & 255, g = (it >> 8) & 3, lp = it >> 10;
            const float* wf = in_ptr(F, I_AWIN) + (size_t)lp * DM * WIN + (size_t)(ko * 8) * WIN + NQKV + g * 128;
#pragma unroll
            for (int q = 0; q < 4; ++q) { const int e = lane + 64 * q, kk = e >> 5, c4 = (e & 31) * 4; const f32x4 x = *(const f32x4*)(wf + (size_t)kk * WIN + c4);
                scr[(c4 + 0) * 8 + kk] = x[0]; scr[(c4 + 1) * 8 + kk] = x[1]; scr[(c4 + 2) * 8 + kk] = x[2]; scr[(c4 + 3) * 8 + kk] = x[3]; }
            LDS_WAIT(); asm volatile("" ::: "memory");
            float acc[4][8];
#pragma unroll
            for (int o = 0; o < 4; ++o)
#pragma unroll
                for (int kk = 0; kk < 8; ++kk) acc[o][kk] = 0.f;
            for (int c = 0; c < 128; ++c) {
                const f32x4 f0 = *(const LAS f32x4*)(scr + c * 8), f1 = *(const LAS f32x4*)(scr + c * 8 + 4);
                const int m0 = (lane * c) & 127, m1 = ((lane + 64) * c) & 127;
                const float t[4] = {tab[m0], tab[m1], tab[128 + m0], tab[128 + m1]};
#pragma unroll
                for (int o = 0; o < 4; ++o) {
#pragma unroll
                    for (int kk = 0; kk < 4; ++kk) { acc[o][kk] += f0[kk] * t[o]; acc[o][4 + kk] += f1[kk] * t[o]; } }
            }
#pragma unroll
            for (int o = 0; o < 4; ++o) { const int pq = o >> 1, k2 = (o & 1) * 64 + lane;
                u32x4 w; w.x = pk2(acc[o][0], acc[o][1]); w.y = pk2(acc[o][2], acc[o][3]); w.z = pk2(acc[o][4], acc[o][5]); w.w = pk2(acc[o][6], acc[o][7]);
                *(u32x4*)((bf16*)(ws + WS_WPQ) + (size_t)lp * 1024 * DM + (size_t)(pq * 512 + g * 128 + k2) * DM + ko * 8) = w; }
            LDS_WAIT(); asm volatile("" ::: "memory");
        }
    }
    {
        bf16* L1b = (bf16*)(ws + WS_L1);
        for (int it = gw; it < 2 * 704; it += NGW) {
            const int j = it / 704; int r = it % 704; bf16* dst = L1b + (size_t)j * 1024 * DM;
            if (r < 192) { const int d = r / 96; transpose_item(in_ptr(F, I_DW1) + (size_t)(j * 2 + d) * DM * 96, 96, 0, 96, dst, DM, d * 128, scr, r % 96, lane); continue; } r -= 192;
            if (r < 192) { const int d = r / 96; transpose_item(in_ptr(F, I_IA1) + (size_t)(j * 2 + d) * DM * 96, 96, 0, 96, dst, DM, 256 + d * 128, scr, r % 96, lane); continue; } r -= 192;
            if (r < 256) { transpose_item(in_ptr(F, I_GG1) + (size_t)j * DM * 256, 256, 0, 256, dst, DM, 512, scr, r, lane); continue; } r -= 256;
            if (j == 1) transpose_item(in_ptr(F, I_V1), 64, 0, 64, dst, DM, 768, scr, r, lane);
        }
        for (int it = gw; it < 2 * 1408; it += NGW) {
            const int j = it / 1408; int r = it % 1408; unsigned char* base = ws + WS_L2 + (size_t)j * 6 * MiB;
            if (r < 384) { const int d = r / 192; transpose_item32(in_ptr(F, I_DW2) + (size_t)(j * 2 + d) * 96 * DM, DM, DM, (bf16*)base, 256, d * DM, d * 128, scr, r % 192, lane); continue; } r -= 384;
            if (r < 384) { const int d = r / 192; transpose_item32(in_ptr(F, I_IA2) + (size_t)(j * 2 + d) * 96 * DM, DM, DM, (bf16*)(base + 2 * MiB), 256, d * DM, d * 128, scr, r % 192, lane); continue; } r -= 384;
            if (r < 512) { transpose_item32(in_ptr(F, I_GG2) + (size_t)j * 256 * DM, DM, DM, (bf16*)(base + 4 * MiB), 256, 0, 0, scr, r, lane); continue; } r -= 512;
            if (j == 1) transpose_item32(in_ptr(F, I_V2), DM, DM, (bf16*)(base + 5 * MiB), 256, 0, 0, scr, r, lane);
        }
        const u32x4 z = {0u, 0u, 0u, 0u};
        for (long idx = gt; idx < (long)2 * 384 * 256; idx += NGT) {
            const int j = (int)(idx / (384 * 256)), r = (int)((idx / 256) % 384), cg = (int)(idx & 255);
            const int row = (r < 128) ? (r >> 5) * 128 + 96 + (r & 31) : 768 + (r - 128);
            if (j == 1 && row >= 768 && row < 832) continue;
            *(u32x4*)(L1b + ((size_t)j * 1024 + row) * DM + cg * 8) = z; }
        for (long idx = gt; idx < (long)2 * 2 * 4096 * 20; idx += NGT) {
            const int ck = (int)(idx % 20), n = (int)((idx / 20) & 4095), sel = (int)((idx / (20 * 4096)) & 1), j = (int)(idx / (2 * 20 * 4096)), d = n >> 11;
            const int chunk = (d == 0) ? 12 + ck : (ck < 16 ? ck : 12 + ck);
            *(u32x4*)((bf16*)(ws + WS_L2 + (size_t)j * 6 * MiB + (size_t)sel * 2 * MiB) + (size_t)n * 256 + chunk * 8) = z; }
        for (long idx = gt; idx < (long)2048 * 24; idx += NGT) {
            const int ck = (int)(idx % 24), n = (int)(idx / 24);
            *(u32x4*)((bf16*)(ws + WS_L2 + (size_t)6 * MiB + 5 * MiB) + (size_t)n * 256 + 64 + ck * 8) = z; }
    }
}

__device__ __forceinline__ void mod_finalize(const Frame& F) {
    PHASE_IDS();
    float* MOD = (float*)(F.ws + WS_CTL) + CW_MOD; const float* PART = (const float*)(F.ws + WS_H); const float* bmod = in_ptr(F, I_BMOD);
    const long gt = (long)F.vcu * 512 + tid, NGT = (long)F.G * 512;
    for (long idx = gt; idx < 4 * 5 * 12288; idx += NGT) { const int n = (int)(idx % 12288), i = (int)(idx / (5 * 12288));
        float sacc = bmod[(size_t)i * 12288 + n];
#pragma unroll
        for (int kc = 0; kc < 8; ++kc) sacc += PART[(size_t)kc * 4 * 5 * 12288 + idx];
        MOD[idx] = sacc; }
}
__device__ __forceinline__ void norm_phase(const Frame& F, int layer, int which, bool first, int fold, bool lat_only) {
    const float* MOD = (const float*)(F.ws + WS_CTL) + CW_MOD;
    bf16* X = (bf16*)(F.ws + WS_X); bf16* H = (bf16*)(F.ws + WS_H); const unsigned short* PART = (const unsigned short*)(F.ws + WS_PART);
    const float* g = (which == 0 ? in_ptr(F, I_N1G) : in_ptr(F, I_N2G)) + (size_t)layer * DM;
    const float* xin = in_ptr(F, I_X); const float* cin = in_ptr(F, I_CTX);
    PHASE_IDS();
#define NP_COL(j_) ((64 * ((j_) >> 1) + lane) * 8 + ((j_) & 1) * 4)
#define NP_SRC(row_) ({ const int b_ = (row_) / TPB, n_ = (row_) % TPB; const float* s_ = (n_ < CTXL) ? cin + ((size_t)b_ * CTXL + n_) * DM : xin + ((size_t)b_ * SEQ + (n_ - CTXL)) * DM; (const f32x4*)s_ + 2 * lane; })
#define NP_LOAD(row_) do { if (first) { const f32x4* xr = NP_SRC(row_); _Pragma("unroll") for (int p = 0; p < 4; ++p) { vn[2 * p] = __builtin_nontemporal_load(xr + 128 * p); vn[2 * p + 1] = __builtin_nontemporal_load(xr + 128 * p + 1); } } \
                           else { const u32x4* xb = (const u32x4*)(X + (size_t)(row_) * DM) + lane; _Pragma("unroll") for (int p = 0; p < 4; ++p) vb[p] = xb[64 * p]; } } while (0)
    f32x4 vn[8]; u32x4 vb[4];
    f32x4 g4[8], gs4[8], sh4[8]; int rc_cur = -1;
#pragma unroll
    for (int j = 0; j < 8; ++j) { g4[j] = *(const f32x4*)(g + NP_COL(j)); gs4[j] = g4[j]; sh4[j] = g4[j]; vn[j] = (f32x4){0.f, 0.f, 0.f, 0.f}; }
#pragma unroll
    for (int p = 0; p < 4; ++p) vb[p] = (u32x4){0u, 0u, 0u, 0u};
    int row = gw;
    if (row < NT) NP_LOAD(row);
    for (; row < NT; row += NGW) {
        const int b = row / TPB, n = row % TPB; const bool isctx = n < CTXL; const int rc = isctx ? 4 : b;
        f32x4 v[8];
#pragma unroll
        for (int p = 0; p < 4; ++p) { v[2 * p] = first ? vn[2 * p] : (f32x4){hlo(vb[p].x), hhi(vb[p].x), hlo(vb[p].y), hhi(vb[p].y)};
                                      v[2 * p + 1] = first ? vn[2 * p + 1] : (f32x4){hlo(vb[p].z), hhi(vb[p].z), hlo(vb[p].w), hhi(vb[p].w)}; }
        if (row + NGW < NT) NP_LOAD(row + NGW);
        if (isctx && lat_only) continue;
        float s = 0.f;
        u32x4* xo = (u32x4*)(X + (size_t)row * DM) + lane;
        if (isctx && fold >= 0) {
            const float* gp = MOD + fold + 4 * 12288; const unsigned short* pp = PART + ((size_t)b * 256 + n) * DM;
#pragma unroll
            for (int p = 0; p < 4; ++p) { f32x4 ps0 = (f32x4){0.f, 0.f, 0.f, 0.f}, ps1 = ps0;
#pragma unroll
                for (int sl = 0; sl < 8; ++sl) { const u32x4 t = *(const u32x4*)(pp + (size_t)sl * 1024 * DM + (64 * p + lane) * 8);
                    ps0 += (f32x4){hlo(t.x), hhi(t.x), hlo(t.y), hhi(t.y)}; ps1 += (f32x4){hlo(t.z), hhi(t.z), hlo(t.w), hhi(t.w)}; }
                v[2 * p] += *(const f32x4*)(gp + NP_COL(2 * p)) * ps0; v[2 * p + 1] += *(const f32x4*)(gp + NP_COL(2 * p + 1)) * ps1;
                u32x4 w; w.x = pk2h(v[2 * p].x, v[2 * p].y); w.y = pk2h(v[2 * p].z, v[2 * p].w); w.z = pk2h(v[2 * p + 1].x, v[2 * p + 1].y); w.w = pk2h(v[2 * p + 1].z, v[2 * p + 1].w); xo[64 * p] = w; }
        }
#pragma unroll
        for (int j = 0; j < 8; ++j) s += (v[j].x * v[j].x + v[j].y * v[j].y) + (v[j].z * v[j].z + v[j].w * v[j].w);
        const float rstd = rsqrtf(wave_sum(s) * (1.0f / DM) + 1e-6f);
        if (first) {
#pragma unroll
            for (int p = 0; p < 4; ++p) { u32x4 w; w.x = pk2h(v[2 * p].x, v[2 * p].y); w.y = pk2h(v[2 * p].z, v[2 * p].w); w.z = pk2h(v[2 * p + 1].x, v[2 * p + 1].y); w.w = pk2h(v[2 * p + 1].z, v[2 * p + 1].w); xo[64 * p] = w; } }
        if (rc != rc_cur) { rc_cur = rc;
            const float* sh = MOD + (size_t)(layer * 5 + rc) * 12288 + (size_t)(which * 3) * DM; const float* sc = sh + DM;
#pragma unroll
            for (int j = 0; j < 8; ++j) { const int col = NP_COL(j); sh4[j] = *(const f32x4*)(sh + col); gs4[j] = g4[j] * (*(const f32x4*)(sc + col) + 1.0f); } }
        u32x4* o8 = (u32x4*)(H + (size_t)row * DM) + lane;
#pragma unroll
        for (int p = 0; p < 4; ++p) { const f32x4 y0 = (v[2 * p] * rstd) * gs4[2 * p] + sh4[2 * p], y1 = (v[2 * p + 1] * rstd) * gs4[2 * p + 1] + sh4[2 * p + 1];
            u32x4 w; w.x = pk2(y0.x, y0.y); w.y = pk2(y0.z, y0.w); w.z = pk2(y1.x, y1.y); w.w = pk2(y1.z, y1.w); o8[64 * p] = w; }
    }
#undef NP_LOAD
#undef NP_SRC
#undef NP_COL
}
__device__ __forceinline__ void final_norm_phase(const Frame& F) {
    const bf16* X = (const bf16*)(F.ws + WS_X); const float* g = in_ptr(F, I_FNG);
    PHASE_IDS();
    f32x4 g4[8];
#pragma unroll
    for (int j = 0; j < 8; ++j) g4[j] = *(const f32x4*)(g + (64 * (j >> 1) + lane) * 8 + (j & 1) * 4);
    for (int r = gw; r < NBATCH * SEQ; r += NGW) {
        const int b = r / SEQ, t = r % SEQ; const size_t row = (size_t)b * TPB + CTXL + t;
        const u32x4* xr = (const u32x4*)(X + row * DM) + lane;
        f32x4 v[8]; float s = 0.f;
#pragma unroll
        for (int p = 0; p < 4; ++p) { const u32x4 t4 = xr[64 * p]; v[2 * p] = (f32x4){hlo(t4.x), hhi(t4.x), hlo(t4.y), hhi(t4.y)}; v[2 * p + 1] = (f32x4){hlo(t4.z), hhi(t4.z), hlo(t4.w), hhi(t4.w)}; }
#pragma unroll
        for (int j = 0; j < 8; ++j) s += (v[j].x * v[j].x + v[j].y * v[j].y) + (v[j].z * v[j].z + v[j].w * v[j].w);
        const float rstd = rsqrtf(wave_sum(s) * (1.0f / DM) + 1e-6f);
        f32x4* o = (f32x4*)((float*)in_ptr(F, 38) + (size_t)r * DM) + 2 * lane;
#pragma unroll
        for (int p = 0; p < 4; ++p) { __builtin_nontemporal_store((v[2 * p] * rstd) * g4[2 * p], o + 128 * p); __builtin_nontemporal_store((v[2 * p + 1] * rstd) * g4[2 * p + 1], o + 128 * p + 1); }
    }
}
__device__ __forceinline__ void deferred_transposes(const Frame& F, const int slot) {
    PHASE_IDS();
    LAS float* scr = (LAS float*)(F.lds + wave * 16384);
    constexpr int P_UP = 32 * 352, P_DN = 88 * 64, P_SQ = 32 * 64;
    const int l = 2 + slot, n_all = P_UP + P_DN + 4 * P_SQ;
    for (int it = F.vcu * 8 + wave; it < n_all; it += 128 * 8) {
        int r = it;
        if (r < P_UP) { transpose_item(in_ptr(F, I_WUP) + (size_t)l * DM * DFF2, DFF2, 0, DFF2, (bf16*)(F.ws + WS_WUP) + (size_t)l * DFF2 * DM, DM, 0, scr, r, lane, true); continue; } r -= P_UP;
        if (r < P_DN) { transpose_item(in_ptr(F, I_WDN) + (size_t)l * DFF * DM, DM, 0, DM, (bf16*)(F.ws + WS_WDN) + (size_t)l * DM * DFF, DFF, 0, scr, r, lane); continue; } r -= P_DN;
        { const int which = r / P_SQ, mi = slot * 4 + which;
          const float* src = (which == 0 ? in_ptr(F, I_WR) : (which == 1 ? in_ptr(F, I_WK) : (which == 2 ? in_ptr(F, I_WV) : in_ptr(F, I_WO)))) + (size_t)slot * DM * DM;
          transpose_item(src, DM, 0, DM, (bf16*)(F.ws + WS_WRKVO) + (size_t)mi * DM * DM, DM, 0, scr, r % P_SQ, lane); }
    }
}
__device__ __forceinline__ void attn_phase(const Frame& F, int lp) {
    const bf16* QKV = (const bf16*)(F.ws + WS_QKV); bf16* MIX = (bf16*)(F.ws + WS_MIX);
    const float* RC = (const float*)(F.ws + WS_ROPEC); const float* RS = (const float*)(F.ws + WS_ROPES); const float* qg = in_ptr(F, I_QG) + (size_t)lp * 128;
    for (int i = 0;; ++i) {
        int uidx;
        if (F.G == 256) { const int v = F.vcu;
            if (v < 128) { if (i < 2) uidx = 2 * v + i; else if (i == 2 && v >= 8 && v < 56) uidx = 768 + (v - 8); else break; }
            else { if (i < 4) uidx = 256 + 4 * (v - 128) + i; else break; } }
        else { uidx = i * F.G + F.vcu; if (uidx >= 816) break; }
        if (uidx < 768) { const int b = uidx / 192, rem = uidx % 192, kvh = rem / 48, r2 = rem % 48, g = r2 >> 4, qb = r2 & 15, hq = kvh * 3 + g;
            const size_t qrow = (size_t)b * TPB + CTXL + qb * 256, krow = (size_t)b * TPB;
            att::attn_unit(QKV + qrow * NQKV + hq * 128, QKV + krow * NQKV + 1536 + kvh * 128, QKV + krow * NQKV + 2048 + kvh * 128, MIX + qrow * DM + hq * 128, TPB,
                           qg, RC + (size_t)qb * 256 * 64, RS + (size_t)qb * 256 * 64, F.ldsg, F.wave);
        } else { const int c = uidx - 768, b = c / 12, hq = c % 12, kvh = hq / 3; const size_t qrow = (size_t)b * TPB;
            att::attn_unit(QKV + qrow * NQKV + hq * 128, QKV + qrow * NQKV + 1536 + kvh * 128, QKV + qrow * NQKV + 2048 + kvh * 128, MIX + qrow * DM + hq * 128, CTXL,
                           qg, nullptr, nullptr, F.ldsg, F.wave);
        }
        __syncthreads();
    }
}
__device__ __forceinline__ void ffn_fixup_phase(const Frame& F, int layer) {
    const bf16* HALO = (const bf16*)(F.ws + WS_HALO); bf16* ACT = (bf16*)(F.ws + WS_ACT);
    const float* cw = in_ptr(F, I_CW) + (size_t)layer * 3 * DFF2; const float* cb = in_ptr(F, I_CB) + (size_t)layer * DFF2;
    PHASE_IDS();
    const long gt = (long)F.vcu * 512 + tid, NGT = (long)F.G * 512;
    for (long idx = gt; idx < (long)NPAN * 2 * 704; idx += NGT) {
        const int c8 = (int)(idx % 704), pe = (int)(idx / 704), pm = pe >> 1, edge = pe & 1, tix = pm % PPB;
        if (tix == 0 || (edge == 0 && tix == 1) || (edge == 1 && tix == PPB - 1)) continue;
        const int ch = c8 * 8, tcol = (ch >> 7) * 256 + (ch & 127);
        const bf16* r0 = HALO + ((size_t)(edge == 0 ? (pm - 1) * 4 + 3 : pm * 4 + 2)) * DFF2 + tcol;
        const bf16* r1 = HALO + ((size_t)(edge == 0 ? pm * 4 + 0 : pm * 4 + 3)) * DFF2 + tcol;
        const bf16* r2 = HALO + ((size_t)(edge == 0 ? pm * 4 + 1 : (pm + 1) * 4 + 0)) * DFF2 + tcol;
        const bf16* rr[3] = {r0, r1, r2};
        float pg[8], pv[8];
#pragma unroll
        for (int e = 0; e < 8; ++e) { pg[e] = cb[ch + e]; pv[e] = cb[DFF + ch + e]; }
#pragma unroll
        for (int t = 0; t < 3; ++t) { const u32x4 ug = *(const u32x4*)rr[t], uv = *(const u32x4*)(rr[t] + 128);
#pragma unroll
            for (int q = 0; q < 4; ++q) { pg[2 * q] += cw[(size_t)t * DFF2 + ch + 2 * q] * bflo(ug[q]); pg[2 * q + 1] += cw[(size_t)t * DFF2 + ch + 2 * q + 1] * bfhi(ug[q]);
                                          pv[2 * q] += cw[(size_t)t * DFF2 + DFF + ch + 2 * q] * bflo(uv[q]); pv[2 * q + 1] += cw[(size_t)t * DFF2 + DFF + ch + 2 * q + 1] * bfhi(uv[q]); } }
        float o[8];
#pragma unroll
        for (int e = 0; e < 8; ++e) o[e] = pg[e] * sigmoidf_(pg[e]) * pv[e];
        u32x4 w; w.x = pk2(o[0], o[1]); w.y = pk2(o[2], o[3]); w.z = pk2(o[4], o[5]); w.w = pk2(o[6], o[7]);
        *(u32x4*)(ACT + (size_t)(pm * 256 + (edge == 0 ? 0 : 255)) * DFF + ch) = w;
    }
}
__device__ __forceinline__ void mixes_phase(const Frame& F, int j) {
    const bf16* H = (const bf16*)(F.ws + WS_H); const float* mu = in_ptr(F, I_MU) + (size_t)j * 6 * DM;
    PHASE_IDS();
    const long gt = (long)F.vcu * 512 + tid, NGT = (long)F.G * 512;
    f32x4 mu0[6], mu1[6];
    { const int cgf = (int)(gt & 255);
#pragma unroll
      for (int m = 0; m < 6; ++m) { mu0[m] = *(const f32x4*)(mu + (size_t)m * DM + cgf * 8); mu1[m] = *(const f32x4*)(mu + (size_t)m * DM + cgf * 8 + 4); } }
    for (long idx0 = gt; idx0 < (long)NT * 256; idx0 += 2 * NGT) {
        u32x4 hc[2], hm[2], hn[2]; bool ok[2];
#pragma unroll
        for (int u = 0; u < 2; ++u) { const long idx = idx0 + u * NGT; ok[u] = idx < (long)NT * 256; hc[u] = hm[u] = hn[u] = (u32x4){0u, 0u, 0u, 0u};
            if (ok[u]) { const int row = (int)(idx >> 8), cg = (int)(idx & 255), n = row % TPB; const bf16* hp = H + (size_t)row * DM + cg * 8;
                hc[u] = *(const u32x4*)hp; if (!(n == 0 || n == CTXL)) hm[u] = *(const u32x4*)(hp - DM); if (!(n == CTXL - 1 || n == TPB - 1)) hn[u] = *(const u32x4*)(hp + DM); } }
#pragma unroll
        for (int u = 0; u < 2; ++u) { if (!ok[u]) continue;
            const long idx = idx0 + u * NGT; const int row = (int)(idx >> 8), cg = (int)(idx & 255);
            float h[8], dx[8];
#pragma unroll
            for (int q = 0; q < 4; ++q) { h[2 * q] = bflo(hc[u][q]); h[2 * q + 1] = bfhi(hc[u][q]);
                dx[2 * q] = 0.5f * (bflo(hm[u][q]) + bflo(hn[u][q])) - h[2 * q]; dx[2 * q + 1] = 0.5f * (bfhi(hm[u][q]) + bfhi(hn[u][q])) - h[2 * q + 1]; }
#pragma unroll
            for (int m = 0; m < 6; ++m) { const f32x4 m0 = mu0[m], m1 = mu1[m];
                float x[8];
#pragma unroll
                for (int e = 0; e < 4; ++e) { x[e] = h[e] + dx[e] * m0[e]; x[4 + e] = h[4 + e] + dx[4 + e] * m1[e]; }
                u32x4 w; w.x = pk2(x[0], x[1]); w.y = pk2(x[2], x[3]); w.z = pk2(x[4], x[5]); w.w = pk2(x[6], x[7]);
                *(u32x4*)((bf16*)(F.ws + WS_MIXES + (size_t)m * MIXSZ) + (size_t)row * DM + cg * 8) = w; }
        }
    }
}
typedef float f32x2 __attribute__((ext_vector_type(2)));
__device__ __forceinline__ float red8(float x) { x += dpp_mov<0x141>(x); x += dpp_mov<0xB1>(x); x += dpp_mov<0x4E>(x); return x; }
__device__ __forceinline__ void scan_prep_phase(const Frame& F, int j, const bf16* Vsrc) {
    const bf16* R = (const bf16*)(F.ws + WS_R); const bf16* K = (const bf16*)(F.ws + WS_K); const unsigned short* AA = (const unsigned short*)(F.ws + WS_AA);
    float* ST = (float*)(F.ws + WS_STATS);
    const float* pkk = in_ptr(F, I_KK) + (size_t)j * DM; const float* pka = in_ptr(F, I_KA) + (size_t)j * DM; const float* prk = in_ptr(F, I_RK) + (size_t)j * DM;
    PHASE_IDS();
    f32x4 wkk[4][2], wka[4][2], wrk[4][2];
#pragma unroll
    for (int q = 0; q < 4; ++q) { const int c0 = q * 512 + lane * 8;
        wkk[q][0] = *(const f32x4*)(pkk + c0); wkk[q][1] = *(const f32x4*)(pkk + c0 + 4); wka[q][0] = *(const f32x4*)(pka + c0); wka[q][1] = *(const f32x4*)(pka + c0 + 4);
        wrk[q][0] = *(const f32x4*)(prk + c0); wrk[q][1] = *(const f32x4*)(prk + c0 + 4); }
    for (int row = gw; row < NT; row += NGW) {
        u32x4 rr[4], kk4[4], a0[4], a1[4];
#pragma unroll
        for (int q = 0; q < 4; ++q) { const size_t o = (size_t)row * DM + q * 512 + lane * 8; rr[q] = *(const u32x4*)(R + o); kk4[q] = *(const u32x4*)(K + o);
            a0[q] = *(const u32x4*)(AA + (size_t)row * 4096 + q * 512 + lane * 8); a1[q] = *(const u32x4*)(AA + (size_t)row * 4096 + DM + q * 512 + lane * 8); }
#pragma unroll
        for (int q = 0; q < 4; ++q) {
            float r[8], k[8], kkw[8], kaw[8], rkw[8];
#pragma unroll
            for (int e = 0; e < 4; ++e) { r[2 * e] = bflo(rr[q][e]); r[2 * e + 1] = bfhi(rr[q][e]); k[2 * e] = bflo(kk4[q][e]); k[2 * e + 1] = bfhi(kk4[q][e]); }
            { const f32x4 x0 = wkk[q][0], x1 = wkk[q][1], y0 = wka[q][0], y1 = wka[q][1], z0 = wrk[q][0], z1 = wrk[q][1];
#pragma unroll
              for (int e = 0; e < 4; ++e) { kkw[e] = x0[e]; kkw[4 + e] = x1[e]; kaw[e] = y0[e]; kaw[4 + e] = y1[e]; rkw[e] = z0[e]; rkw[4 + e] = z1[e]; } }
            float n2 = 0.f;
#pragma unroll
            for (int e = 0; e < 8; ++e) { const float t = k[e] * kkw[e]; n2 += t * t; }
            const float ninv = 1.0f / fmaxf(sqrtf(red8(n2)), 1e-12f);
            float st[6];
#pragma unroll
            for (int d = 0; d < 2; ++d) { float br = 0.f, kr = 0.f, bon = 0.f;
#pragma unroll
                for (int e = 0; e < 8; ++e) { const unsigned aw = (d == 0) ? a0[q][e >> 1] : a1[q][e >> 1]; const float a = h2f((unsigned short)((e & 1) ? (aw >> 16) : (aw & 0xffffu)));
                    const float kd = k[e] * (1.0f + (a - 1.0f) * kaw[e]);
                    bon += r[e] * kd * rkw[e]; }
                st[3 * d] = 0.f; st[3 * d + 1] = 0.f; st[3 * d + 2] = red8(bon); (void)br; (void)kr; }
            if ((lane & 7) == 0) { float* o = ST + ((size_t)row * 32 + q * 8 + (lane >> 3)) * 8; *(f32x4*)o = (f32x4){ninv, st[0], st[1], st[2]}; *(f32x4*)(o + 4) = (f32x4){st[3], st[4], st[5], 0.f}; }
        }
    }
    (void)Vsrc;
}
typedef short bf16x4 __attribute__((ext_vector_type(4)));
constexpr int CS_KS = 72, CS_TS = 36;
constexpr int CS_AL = 0, CS_RH = 16 * CS_KS * 2, CS_BE = 2 * CS_RH, CS_KA = 3 * CS_RH, CS_BPT = 4 * CS_RH, CS_UV = CS_BPT + 64 * CS_TS * 2, CS_PC = CS_UV + 64 * CS_TS * 2, CS_OPS = CS_PC + 256;
constexpr int CS_FR = 3 * CS_OPS, CS_FRSZ = 7 * 512, CS_RAWB = CS_FR + 2 * CS_FRSZ, CS_RAWSZ = 3 * 1024, CS_END = CS_RAWB + 4 * 3 * CS_RAWSZ;
static_assert(CS_END + 4 * 256 <= RING_BYTES, "chunked scan LDS");
#define CS_MFMA(a_, b_, c_) __builtin_amdgcn_mfma_f32_16x16x32_bf16(a_, b_, c_, 0, 0, 0)
#define CS_MFMA16(a_, b_, c_) __builtin_amdgcn_mfma_f32_16x16x16bf16_1k(a_, b_, c_, 0, 0, 0)
__device__ __forceinline__ bf16x4 cs_cvt4(const f32x4 x) { const u32x2 w = (u32x2){cvt_pk_bf16(x[0], x[1]), cvt_pk_bf16(x[2], x[3])}; return __builtin_bit_cast(bf16x4, w); }
__device__ __forceinline__ void scan_phase_chunked(const Frame& F, int j, const bf16* Vsrc) {
    const bf16* R = (const bf16*)(F.ws + WS_R); const bf16* K = (const bf16*)(F.ws + WS_K);
    const unsigned short* E = (const unsigned short*)(F.ws + WS_E); const unsigned short* AA = (const unsigned short*)(F.ws + WS_AA);
    bf16* Y = (bf16*)(F.ws + WS_Y); const float* ST = (const float*)(F.ws + WS_STATS);
    LAS unsigned char* L = F.lds;
    PHASE_IDS();
    const int q4 = lane >> 4, cc = lane & 15;
    const f32x4 z4 = (f32x4){0.f, 0.f, 0.f, 0.f};
    const bf16x4 zf4 = (bf16x4){0, 0, 0, 0};
    for (int s = blockIdx.x; s < 256; s += F.G) {
        const int b = s >> 6, h = (s >> 1) & 31, d = s & 1;
        bf16* Yd = Y + (size_t)d * NT * DM;
        const int kch = ((wave - 4) & 3) * 16 + cc, ch = h * 64 + kch;
        float kkw = in_ptr(F, I_KK)[(size_t)j * DM + ch], kaw = in_ptr(F, I_KA)[(size_t)j * DM + ch];
        asm volatile("" : "+v"(kkw), "+v"(kaw));
#define CS_ROW(chunk_, tl_) ((size_t)b * TPB + ((d == 0) ? ((chunk_) * 16 + (tl_)) : (((chunk_) < 16) ? (CTXL - 1 - ((chunk_) * 16 + (tl_))) : ((TPB + CTXL - 1) - ((chunk_) * 16 + (tl_))))))
        const int pw = (wave - 4) & 3;
        LAS unsigned char* RW = L + CS_RAWB + pw * 3 * CS_RAWSZ;
        LAS unsigned char* GT = L + CS_END + pw * 256;
        const char* dbase[3]; unsigned dpitch[3];
#pragma unroll
        for (int jd = 0; jd < 3; ++jd) { int g = jd * 64 + lane; if (g > 175) g = 175;
            if (g < 160) { const int a = g >> 5, t = (g >> 1) & 15, hf = g & 1, dro = (d == 0) ? t : 15 - t;
                const char* ab = (a == 0) ? (const char*)R : (a == 1 ? (const char*)K : (a == 2 ? (const char*)Vsrc : (a == 3 ? (const char*)E : (const char*)AA)));
                dpitch[jd] = (a < 3) ? (unsigned)(DM * 2) : 8192u;
                dbase[jd] = ab + (size_t)dro * dpitch[jd] + (size_t)((h * 64 + pw * 16 + hf * 8) * 2 + (a < 3 ? 0 : d * DM * 2)); }
            else { const int t = g - 160, dro = (d == 0) ? t : 15 - t; dpitch[jd] = 1024u; dbase[jd] = (const char*)ST + (size_t)((dro * 32 + h) * 32); } }
#define CS_RAW(chunk_, slot_) do { const unsigned rb_ = (unsigned)__builtin_amdgcn_readfirstlane((int)CS_ROW(chunk_, (d == 0) ? 0 : 15)); \
            _Pragma("unroll") for (int jd = 0; jd < 3; ++jd) \
                __builtin_amdgcn_global_load_lds((const unsigned*)(dbase[jd] + (size_t)rb_ * dpitch[jd]), (LAS unsigned*)(RW + (slot_) * CS_RAWSZ + jd * 1024), 16, 0, 0); } while (0)
        const int rd_off = cc * 2;
#define CS_GET16(slot_, a_, tl_) (*(const LAS unsigned short*)(RW + (slot_) * CS_RAWSZ + (a_) * 512 + rd_off + (tl_) * 32))
        f32x4 S[4];
#pragma unroll
        for (int nb = 0; nb < 4; ++nb) S[nb] = z4;
        const int vb = (wave & 3) * 16;
        if (wave >= 4) { CS_RAW(0, 0); CS_RAW(1, 1); }
        asm volatile("s_waitcnt lgkmcnt(0)" ::: "memory"); __builtin_amdgcn_s_barrier(); asm volatile("" ::: "memory");
#define CS_BAR() do { asm volatile("s_waitcnt lgkmcnt(0)" ::: "memory"); __builtin_amdgcn_s_barrier(); asm volatile("" ::: "memory"); } while (0)
#define CS_PROD(P, it, m3) do { \
                const bool do_ops = it < 272; \
                LAS unsigned char* O = L + (m3) * CS_OPS; \
                if (do_ops) { \
                    float rf[4], kf[4], wf[4], af[4], nf[4], cp[4]; unsigned short vr[4]; \
                    asm volatile("s_waitcnt vmcnt(3)" ::: "memory"); \
_Pragma("unroll") \
                    for (int q = 0; q < 4; ++q) { const int tl_ = 4 * q4 + q, sl_ = (m3); rf[q] = bf2f(CS_GET16(sl_, 0, tl_)); kf[q] = bf2f(CS_GET16(sl_, 1, tl_)); vr[q] = CS_GET16(sl_, 2, tl_); wf[q] = __expf(-h2f(CS_GET16(sl_, 3, tl_))); af[q] = h2f(CS_GET16(sl_, 4, tl_)); nf[q] = *(const LAS float*)(RW + sl_ * CS_RAWSZ + 2560 + tl_ * 16); } \
                    asm volatile("s_waitcnt lgkmcnt(0)" ::: "memory"); CS_RAW(it + 2 < 272 ? it + 2 : 271, ((m3) + 2) % 3); \
                    cp[0] = wf[0]; cp[1] = cp[0] * wf[1]; cp[2] = cp[1] * wf[2]; cp[3] = cp[2] * wf[3]; \
                    *(LAS float*)(GT + (cc * 4 + q4) * 4) = cp[3];     \
                    const f32x4 gt = *(const LAS f32x4*)(GT + cc * 16); \
                    const float ex = ((q4 >= 1) ? gt[0] : 1.0f) * ((q4 >= 2) ? gt[1] : 1.0f) * ((q4 >= 3) ? gt[2] : 1.0f); \
                    const float pc = (gt[0] * gt[1]) * (gt[2] * gt[3]); \
_Pragma("unroll") \
                    for (int q = 0; q < 4; ++q) { const int tl = 4 * q4 + q; \
                        const float Pt = ex * cp[q], Pm = (q == 0) ? ex : ex * cp[q > 0 ? q - 1 : 0], rP = __builtin_amdgcn_rcpf(Pt), dc = pc * rP; \
                        const float kk = kf[q] * kkw * nf[q], kd = kf[q] * (1.0f + (af[q] - 1.0f) * kaw), bb = kk * af[q]; \
                        const unsigned p0 = cvt_pk_bf16(-kk * Pm, rf[q] * Pt), p1 = cvt_pk_bf16(bb * rP, kd * rP), p2 = cvt_pk_bf16(bb * dc, kd * dc); \
                        *(LAS unsigned short*)(O + CS_AL + (tl * CS_KS + kch) * 2) = (unsigned short)p0; *(LAS unsigned short*)(O + CS_RH + (tl * CS_KS + kch) * 2) = (unsigned short)(p0 >> 16); \
                        *(LAS unsigned short*)(O + CS_BE + (tl * CS_KS + kch) * 2) = (unsigned short)p1; *(LAS unsigned short*)(O + CS_KA + (tl * CS_KS + kch) * 2) = (unsigned short)(p1 >> 16); \
                        *(LAS unsigned short*)(O + CS_BPT + (kch * CS_TS + tl) * 2) = (unsigned short)p2; *(LAS unsigned short*)(O + CS_BPT + (kch * CS_TS + 16 + tl) * 2) = (unsigned short)(p2 >> 16); \
                        *(LAS unsigned short*)(O + CS_UV + (kch * CS_TS + 16 + tl) * 2) = vr[q]; } \
                    if (q4 == 0) *(LAS float*)(O + CS_PC + kch * 4) = pc; \
                } \
        } while (0)
#define CS_NMAT(P, it, m3) do { \
                if (it >= 1 && it < 273) { \
                    const LAS unsigned char* On = L + (((m3) + 2) % 3) * CS_OPS; LAS unsigned char* FR = L + CS_FR + ((it + 1) & 1) * CS_FRSZ; \
                    LAS bf16x4* fr = (LAS bf16x4*)FR + lane; \
                    if (wave == 0) { \
                        const bf16x8 be0 = *(const LAS bf16x8*)(On + CS_BE + (cc * CS_KS + q4 * 8) * 2), be1 = *(const LAS bf16x8*)(On + CS_BE + (cc * CS_KS + 32 + q4 * 8) * 2); \
                        const bf16x8 al0 = *(const LAS bf16x8*)(On + CS_AL + (cc * CS_KS + q4 * 8) * 2), al1 = *(const LAS bf16x8*)(On + CS_AL + (cc * CS_KS + 32 + q4 * 8) * 2); \
                        f32x4 P = CS_MFMA(be1, al1, CS_MFMA(be0, al0, z4)); \
                        f32x4 Q = CS_MFMA(al1, be1, CS_MFMA(al0, be0, z4)); \
                        _Pragma("unroll") for (int jj = 0; jj < 4; ++jj) { const int rr = 4 * q4 + jj; if (!(rr < cc)) P[jj] = 0.f; if (!(cc < rr)) Q[jj] = 0.f; } \
                        bf16x4 pb = cs_cvt4(P), qb = cs_cvt4(Q); fr[1 * 64] = pb; \
                        _Pragma("unroll") for (int p = 0; p < 3; ++p) { const f32x4 P2 = CS_MFMA16(qb, pb, z4), Q2 = CS_MFMA16(pb, qb, z4); \
                            pb = cs_cvt4(P2); qb = cs_cvt4(Q2); fr[(2 + p) * 64] = pb; } \
                    } else { \
                        const int lo_ = (wave == 2) ? CS_BE : CS_KA, ro_ = (wave == 1) ? CS_AL : CS_RH, slot_ = (wave == 1) ? 0 : ((wave == 2) ? 5 : 6); \
                        const bf16x8 x0 = *(const LAS bf16x8*)(On + lo_ + (cc * CS_KS + q4 * 8) * 2), x1 = *(const LAS bf16x8*)(On + lo_ + (cc * CS_KS + 32 + q4 * 8) * 2); \
                        const bf16x8 y0 = *(const LAS bf16x8*)(On + ro_ + (cc * CS_KS + q4 * 8) * 2), y1 = *(const LAS bf16x8*)(On + ro_ + (cc * CS_KS + 32 + q4 * 8) * 2); \
                        f32x4 nn = CS_MFMA(x1, y1, CS_MFMA(x0, y0, z4)); \
                        _Pragma("unroll") for (int jj = 0; jj < 4; ++jj) { const int rr = 4 * q4 + jj; const bool keep = (wave == 1) ? (rr < cc) : (rr <= cc); if (!keep) nn[jj] = 0.f; } \
                        fr[slot_ * 64] = cs_cvt4(nn); \
                    } \
                } \
        } while (0)
#define CS_CONS(it, m3) do { \
                const int c = it - 2; \
                const LAS unsigned char* O = L + (((m3) + 1) % 3) * CS_OPS; const LAS bf16x4* fr = (const LAS bf16x4*)(L + CS_FR + (c & 1) * CS_FRSZ) + lane; \
                bf16x4 aA[4], aR[4], bu[4], bv[4]; f32x4 pc4[4]; \
_Pragma("unroll") \
                for (int nb = 0; nb < 4; ++nb) { aA[nb] = *(const LAS bf16x4*)(O + CS_AL + (cc * CS_KS + 16 * nb + 4 * q4) * 2); aR[nb] = *(const LAS bf16x4*)(O + CS_RH + (cc * CS_KS + 16 * nb + 4 * q4) * 2); \
                    bu[nb] = *(const LAS bf16x4*)(O + CS_BPT + ((16 * nb + cc) * CS_TS + 4 * q4) * 2); bv[nb] = *(const LAS bf16x4*)(O + CS_BPT + ((16 * nb + cc) * CS_TS + 16 + 4 * q4) * 2); \
                    pc4[nb] = *(const LAS f32x4*)(O + CS_PC + (16 * nb + 4 * q4) * 4); } \
                const bf16x4 vT = *(const LAS bf16x4*)(O + CS_UV + ((vb + cc) * CS_TS + 16 + 4 * q4) * 2); \
                const bf16x4 fN2 = fr[0], fP1 = fr[64], fP2 = fr[128], fP4 = fr[192], fP8 = fr[256], fN3 = fr[320], fN4 = fr[384]; \
                f32x4 X = z4, Yt = z4; \
_Pragma("unroll") \
                for (int nb = 0; nb < 4; ++nb) { const bf16x4 sb = cs_cvt4(S[nb]); X = CS_MFMA16(aA[nb], sb, X); Yt = CS_MFMA16(aR[nb], sb, Yt); } \
                X = CS_MFMA16(fN2, vT, X); \
                X = CS_MFMA16(fP1, cs_cvt4(X), X); X = CS_MFMA16(fP2, cs_cvt4(X), X); X = CS_MFMA16(fP4, cs_cvt4(X), X); X = CS_MFMA16(fP8, cs_cvt4(X), X); \
                const bf16x4 ub = cs_cvt4(X); \
_Pragma("unroll") \
                for (int nb = 0; nb < 4; ++nb) S[nb] = CS_MFMA16(bv[nb], vT, CS_MFMA16(bu[nb], ub, S[nb] * pc4[nb])); \
                Yt = CS_MFMA16(fN4, vT, CS_MFMA16(fN3, ub, Yt)); \
                { const unsigned y01 = cvt_pk_bf16(Yt[0], Yt[1]), y23 = cvt_pk_bf16(Yt[2], Yt[3]); \
                  char* yb = ybase + (size_t)__builtin_amdgcn_readfirstlane((int)CS_ROW(c, (d == 0) ? 0 : 15)) * (DM * 2);     \
                  *(bf16*)(yb + yo) = (bf16)y01; *(bf16*)(yb + (yo + ystep)) = (bf16)(y01 >> 16); *(bf16*)(yb + (yo + 2 * ystep)) = (bf16)y23; *(bf16*)(yb + (yo + 3 * ystep)) = (bf16)(y23 >> 16); } \
        } while (0)
        if (wave >= 4) {
            for (int it3 = 0; it3 < 273; it3 += 3) { CS_PROD(A, it3, 0); CS_BAR(); CS_PROD(B, (it3 + 1), 1); CS_BAR(); CS_PROD(C, (it3 + 2), 2); CS_BAR(); }
            CS_BAR();
        } else {
            char* ybase = (char*)Yd + (h * 64) * 2;
            const unsigned yo = (unsigned)(((d == 0) ? 4 * q4 : 15 - 4 * q4) * (DM * 2) + (vb + cc) * 2), ystep = (d == 0) ? (unsigned)(DM * 2) : (unsigned)(-(DM * 2));
            CS_BAR(); CS_NMAT(D, 1, 1); CS_BAR();
            for (int it3 = 2; it3 < 272; it3 += 3) { CS_CONS(it3, 2); CS_NMAT(A, it3, 2); CS_BAR(); CS_CONS((it3 + 1), 0); CS_NMAT(B, (it3 + 1), 0); CS_BAR(); CS_CONS((it3 + 2), 1); CS_NMAT(C, (it3 + 2), 1); CS_BAR(); }
            CS_CONS(272, 2); CS_NMAT(E, 272, 2); CS_BAR(); CS_CONS(273, 0); CS_BAR();
        }
#undef CS_PROD
#undef CS_CONS
#undef CS_NMAT
#undef CS_BAR
        asm volatile("s_waitcnt vmcnt(0)" ::: "memory");
#undef CS_RAW
#undef CS_DMA
#undef CS_GET16
#undef CS_ROW
    }
}
__device__ __forceinline__ void post_phase(const Frame& F, int j, const bf16* Vsrc) {
    const bf16* Y0 = (const bf16*)(F.ws + WS_Y); const bf16* Y1 = Y0 + (size_t)NT * DM; const float* ST = (const float*)(F.ws + WS_STATS);
    const bf16* Gg = (const bf16*)(F.ws + WS_G); bf16* OA = (bf16*)(F.ws + WS_OA);
    const float* lg = in_ptr(F, I_LNG) + (size_t)j * DM; const float* lb = in_ptr(F, I_LNB) + (size_t)j * DM;
    PHASE_IDS();
    f32x4 lgv[4][2], lbv[4][2];
#pragma unroll
    for (int q = 0; q < 4; ++q) { const int c0 = q * 512 + lane * 8; lgv[q][0] = *(const f32x4*)(lg + c0); lgv[q][1] = *(const f32x4*)(lg + c0 + 4); lbv[q][0] = *(const f32x4*)(lb + c0); lbv[q][1] = *(const f32x4*)(lb + c0 + 4); }
    for (int row = gw; row < NT; row += NGW) {
        const size_t ro = (size_t)row * DM + lane * 8;
        u32x4 y0[4], y1[4], vv[4], gg[4]; f32x2 bs[4];
#pragma unroll
        for (int q = 0; q < 4; ++q) { y0[q] = *(const u32x4*)(Y0 + ro + q * 512); y1[q] = *(const u32x4*)(Y1 + ro + q * 512); vv[q] = *(const u32x4*)(Vsrc + ro + q * 512); gg[q] = *(const u32x4*)(Gg + ro + q * 512);
            { const float* sp = ST + ((size_t)row * 32 + q * 8 + (lane >> 3)) * 8; bs[q] = (f32x2){sp[3], sp[6]}; } }
#pragma unroll
        for (int q = 0; q < 4; ++q) {
            float y[8]; float sm = 0.f;
#pragma unroll
            for (int e = 0; e < 4; ++e) { y[2 * e] = bflo(y0[q][e]) + bflo(y1[q][e]); y[2 * e + 1] = bfhi(y0[q][e]) + bfhi(y1[q][e]); sm += y[2 * e] + y[2 * e + 1]; }
            const float mean = red8(sm) * (1.0f / 64.0f); float qq = 0.f;
#pragma unroll
            for (int e = 0; e < 8; ++e) { y[e] -= mean; qq += y[e] * y[e]; }
            const float rstd = rsqrtf(red8(qq) * (1.0f / 64.0f) + 64e-5f), bsum = bs[q].x + bs[q].y;
            const f32x4 l0 = lgv[q][0], l1 = lgv[q][1], b0 = lbv[q][0], b1 = lbv[q][1];
            float o[8];
#pragma unroll
            for (int e = 0; e < 4; ++e) {
                const float v0 = bflo(vv[q][e]), v1 = bfhi(vv[q][e]), g0 = bflo(gg[q][e]), g1 = bfhi(gg[q][e]);
                const float la = (2 * e < 4) ? l0[2 * e] : l1[2 * e - 4], lc = (2 * e + 1 < 4) ? l0[2 * e + 1] : l1[2 * e + 1 - 4];
                const float ba = (2 * e < 4) ? b0[2 * e] : b1[2 * e - 4], bc = (2 * e + 1 < 4) ? b0[2 * e + 1] : b1[2 * e + 1 - 4];
                o[2 * e] = (y[2 * e] * rstd * la + ba + bsum * v0) * g0; o[2 * e + 1] = (y[2 * e + 1] * rstd * lc + bc + bsum * v1) * g1; }
            u32x4 w; w.x = pk2(o[0], o[1]); w.y = pk2(o[2], o[3]); w.z = pk2(o[4], o[5]); w.w = pk2(o[6], o[7]);
            *(u32x4*)(OA + ro + q * 512) = w;
        }
    }
}

#ifndef DUP_SCAN
#define DUP_SCAN 1
#endif
#ifndef DUP_ELT
#define DUP_ELT 1
#endif
#ifndef DUP_ATT
#define DUP_ATT 1
#endif
#ifndef DUP_UP
#define DUP_UP 1
#endif
#ifndef DUP_PROJ
#define DUP_PROJ 1
#endif
#ifndef DUP_RES
#define DUP_RES 1
#endif
#ifndef DUP_L2
#define DUP_L2 1
#endif
#ifndef DUP_P0
#define DUP_P0 1
#endif
#ifndef DUP_BAR
#define DUP_BAR 1
#endif
#define REP(n) _Pragma("nounroll") for (int rep_ = 0; rep_ < opaque_s(n); ++rep_)
__global__ void __launch_bounds__(512, 2) mega_fwd(Args args) {
    extern __shared__ __attribute__((aligned(16))) unsigned char lds[];
    Frame F;
    F.lds = (LAS unsigned char*)lds; F.ldsg = (char*)lds;
    F.G = gridDim.x; { const int bx = blockIdx.x; F.vcu = (F.G % 8 == 0) ? (bx % 8) * (F.G / 8) + bx / 8 : bx; }
    F.NGW = F.G * 8; F.wave = __builtin_amdgcn_readfirstlane((int)(threadIdx.x >> 6));
    F.ws = args.ws;
    unsigned char* ws = args.ws;
    volatile LAS unsigned* MISC = (volatile LAS unsigned*)(F.lds + MISC_OFF);
    for (int u = threadIdx.x; u < (LDS_BYTES - RING_BYTES) / 4; u += 512) ((LAS unsigned*)(F.lds + RING_BYTES))[u] = 0u;
    __syncthreads();
    if (threadIdx.x == 0) { LAS unsigned long long* tab = (LAS unsigned long long*)(F.lds + PTAB_OFF);
#pragma unroll
        for (int i = 0; i < 38; ++i) tab[i] = (unsigned long long)args.in[i];
        tab[38] = (unsigned long long)args.out; }
    __syncthreads();
    XcdBarrier bar = xcd_barrier_post((unsigned*)(ws + WS_CTL) + CW_BAR, MISC + 8); bar.wave = F.wave;
#define GRID_BAR() do { REP(DUP_BAR) xcd_barrier(bar); } while (0)
    const float* MOD = (const float*)(ws + WS_CTL) + CW_MOD;
    const int c = (int)blockIdx.x;

    REP(DUP_P0) p0_prologue(F);
    GRID_BAR();
    mod_finalize(F);
    GRID_BAR();

    for (int layer = 0; layer < 4; ++layer) {
        const int lp = layer >> 1;
        const bool last = (layer == 3);
        REP(DUP_ELT) norm_phase(F, layer, 0, layer == 0, layer == 0 ? -1 : ((layer - 1) * 5 * 12288 + 5 * DM), false);
        GRID_BAR();
        if ((layer & 1) == 0) {
            {
                pg8::SchedInproj S{(const char*)(ws + WS_H), (const char*)(ws + WS_WQKV + (size_t)lp * 10 * MiB), (const char*)(ws + WS_WPQ + (size_t)lp * 4 * MiB), F.G, c};
                pg8::EpiInproj E{(bf16*)(ws + WS_QKV), (bf16*)(ws + WS_T), in_ptr(F, I_QG) + (size_t)lp * 128, in_ptr(F, I_KG) + (size_t)lp * 128,
                                 (const float*)(ws + WS_ROPEC), (const float*)(ws + WS_ROPES), F.lds + EX_OFF};
                REP(DUP_PROJ) pg8::gemm_phase(F.lds, F.wave, DM, DM, S, E);
            }
            GRID_BAR();
            REP(DUP_ATT) {
                {
                pg8::SchedDft S{(const char*)(ws + WS_ADFT), (const char*)(ws + WS_T), F.G, F.vcu};
                pg8::EpiStore E{(bf16*)(ws + WS_MIX), DM};
                pg8::gemm_phase(F.lds, F.wave, 8192, TLD, S, E);
                }
                __syncthreads();
                attn_phase(F, lp);
            }
            if (F.G == 256 && F.vcu < 128) { deferred_transposes(F, layer >> 1); }
            GRID_BAR();
        } else {
            REP(DUP_ELT) mixes_phase(F, lp);
            GRID_BAR();
            bf16* Vdst = (bf16*)(ws + (lp == 0 ? WS_VFIRST : WS_V));
            {
                pg8::SchedRkvl S{(const char*)(ws + WS_MIXES), (const char*)(ws + WS_WRKVO + (size_t)lp * 32 * MiB), (const char*)(ws + WS_L1 + (size_t)lp * 4 * MiB), F.G, c};
                pg8::EpiRkvl E{(bf16*)(ws + WS_R), (bf16*)(ws + WS_K), Vdst, (bf16*)(ws + WS_L)};
                REP(DUP_PROJ) pg8::gemm_phase(F.lds, F.wave, DM, DM, S, E);
            }
            GRID_BAR();
            {
                pg8::SchedLora2 S{(const char*)(ws + WS_L), (const char*)(ws + WS_L2 + (size_t)lp * 6 * MiB), lp == 0 ? 40 : 48, F.G, c};
                pg8::EpiLora2 E{(unsigned short*)(ws + WS_E), (unsigned short*)(ws + WS_AA), (bf16*)(ws + WS_G), (bf16*)(ws + WS_V), (const bf16*)(ws + WS_VFIRST),
                                in_ptr(F, I_DW0) + (size_t)lp * 2 * DM, in_ptr(F, I_IA0) + (size_t)lp * 2 * DM, in_ptr(F, I_V0)};
                pg8::gemm_phase(F.lds, F.wave, 1024, 256, S, E);
                if (DUP_L2 > 1) { GRID_BAR(); pg8::SchedLora2 S2{(const char*)(ws + WS_L), (const char*)(ws + WS_L2 + (size_t)lp * 6 * MiB), 40, F.G, c}; pg8::gemm_phase(F.lds, F.wave, 1024, 256, S2, E); }
            }
            GRID_BAR();
            scan_prep_phase(F, lp, Vdst);
            GRID_BAR();
            REP(DUP_SCAN) scan_phase_chunked(F, lp, Vdst);
            GRID_BAR();
            REP(DUP_ELT) post_phase(F, lp, Vdst);
            GRID_BAR();
        }
        {
            const char* Aop = (const char*)(ws + ((layer & 1) == 0 ? WS_MIX : WS_OA));
            const char* Bop = (const char*)(ws + ((layer & 1) == 0 ? WS_WOUT + (size_t)lp * 8 * MiB : WS_WRKVO + (size_t)(lp * 4 + 3) * 8 * MiB));
            pg8::SchedRes S{Aop, Bop, (size_t)256 * DM * 2, (size_t)256 * DM * 2, 32, last ? 1 : 0, F.G, c};
            pg8::EpiResid E{(bf16*)(ws + WS_X), MOD + (size_t)layer * 5 * 12288 + 2 * DM, (unsigned short*)(ws + WS_PART)};
            pg8::gemm_phase(F.lds, F.wave, DM, DM, S, E);
            if (DUP_RES > 1) { GRID_BAR(); pg8::EpiResid E0{(bf16*)(ws + WS_X), (const float*)(ws + WS_CTL) + 262144, (unsigned short*)(ws + WS_PART)}; pg8::gemm_phase(F.lds, F.wave, DM, DM, S, E0); }
        }
        GRID_BAR();
        REP(DUP_ELT) norm_phase(F, layer, 1, false, last ? -1 : (layer * 5 * 12288 + 2 * DM), last);
        GRID_BAR();
        {
            pg8::SchedSimple S{(const char*)(ws + WS_H), (const char*)(ws + WS_WUP + (size_t)layer * 44 * MiB), (size_t)256 * DM * 2, (size_t)256 * DM * 2, last ? 64 : NPAN, 44, 32, F.G, c};
            pg8::EpiUpConv E{(bf16*)(ws + WS_ACT), (bf16*)(ws + WS_HALO), in_ptr(F, I_CW) + (size_t)layer * 3 * DFF2, in_ptr(F, I_CB) + (size_t)layer * DFF2, F.lds + EX_OFF};
            REP(DUP_UP) pg8::gemm_phase(F.lds, F.wave, DM, DM, S, E);
        }
        GRID_BAR();
        ffn_fixup_phase(F, layer);
        GRID_BAR();
        {
            pg8::SchedRes S{(const char*)(ws + WS_ACT), (const char*)(ws + WS_WDN + (size_t)layer * 22 * MiB), (size_t)256 * DFF * 2, (size_t)256 * DFF * 2, 88, last ? 1 : 0, F.G, c};
            pg8::EpiResid E{(bf16*)(ws + WS_X), MOD + (size_t)layer * 5 * 12288 + 5 * DM, (unsigned short*)(ws + WS_PART)};
            pg8::gemm_phase(F.lds, F.wave, DFF, DFF, S, E);
            if (DUP_RES > 1) { GRID_BAR(); pg8::EpiResid E0{(bf16*)(ws + WS_X), (const float*)(ws + WS_CTL) + 262144, (unsigned short*)(ws + WS_PART)}; pg8::gemm_phase(F.lds, F.wave, DFF, DFF, S, E0); }
        }
        GRID_BAR();
    }
    final_norm_phase(F);
}

extern "C" void kernel_launch(void* const* d_in, const int* in_sizes, int n_in, void* d_out, int out_size, void* d_ws, size_t ws_size, hipStream_t stream) {
    static int grid = 0;
    if (grid == 0) {
        if (n_in != 38 || in_sizes[0] != NBATCH * SEQ * DM || out_size != NBATCH * SEQ * DM || ws_size < WS_END) {
            fprintf(stderr, "kernel_launch: shape/workspace mismatch (n_in %d, ws %zu, need %zu); nothing launched\n", n_in, ws_size, (size_t)WS_END); grid = -1; return; }
        int dev = 0, cus = 0;
        if (hipGetDevice(&dev) != hipSuccess || hipDeviceGetAttribute(&cus, hipDeviceAttributeMultiprocessorCount, dev) != hipSuccess) { grid = -1; return; }
        if (hipFuncSetAttribute((const void*)mega_fwd, hipFuncAttributeMaxDynamicSharedMemorySize, LDS_BYTES) != hipSuccess) { fprintf(stderr, "kernel_launch: hipFuncSetAttribute failed\n"); grid = -1; return; }
        int per_cu = 0;
        if (hipOccupancyMaxActiveBlocksPerMultiprocessor(&per_cu, (const void*)mega_fwd, 512, LDS_BYTES) != hipSuccess || per_cu < 1) { fprintf(stderr, "kernel_launch: occupancy query says %d\n", per_cu); }
        (void)hipGetLastError();
        grid = cus;
    }
    if (grid < 0) return;
    if (hipMemsetAsync((char*)d_ws + WS_CTL, 0, CTL_ZERO_BYTES, stream) != hipSuccess) return;
    Args a{};
    for (int i = 0; i < 38; ++i) a.in[i] = (const float*)d_in[i];
    a.out = (float*)d_out; a.ws = (unsigned char*)d_ws;
    hipLaunchKernelGGL(mega_fwd, dim3(grid), dim3(512), LDS_BYTES, stream, a);
    const hipError_t le = hipPeekAtLastError();
    if (le != hipSuccess) fprintf(stderr, "kernel_launch: launch failed: %s\n", hipGetErrorName(le));
}
```

```cpp
#include <hip/hip_runtime.h>
#include <cstdio>
#include <cstdint>

#define LAS __attribute__((address_space(3)))
typedef unsigned short bf16;
typedef short bf16x8 __attribute__((ext_vector_type(8)));
typedef short s16x4 __attribute__((ext_vector_type(4)));
typedef float f32x4 __attribute__((ext_vector_type(4)));
typedef float f32x16 __attribute__((ext_vector_type(16)));
typedef unsigned u32x4 __attribute__((ext_vector_type(4)));
typedef unsigned u32x2 __attribute__((ext_vector_type(2)));

constexpr int DM = 2048, NBATCH = 4, SEQ = 4096, CTXL = 256, TPB = SEQ + CTXL, NT = NBATCH * TPB, NPAN = NT / 256, PPB = TPB / 256;
constexpr int DFF = 5632, DFF2 = 11264, NQKV = 2560, TLD = 8704, WIN = 3072;
static_assert(NT == 17408 && NPAN == 68 && PPB == 17, "shapes");

constexpr size_t MiB = 1u << 20;
constexpr size_t WS_CTL = 0, CTL_ZERO_BYTES = 2 * MiB;
constexpr size_t WS_ROPEC = 2 * MiB, WS_ROPES = 3 * MiB;
constexpr size_t WS_WUP = 4 * MiB;
constexpr size_t WS_WDN = 180 * MiB;
constexpr size_t WS_WQKV = 268 * MiB;
constexpr size_t WS_WPQ = 288 * MiB;
constexpr size_t WS_WOUT = 296 * MiB;
constexpr size_t WS_WRKVO = 312 * MiB;
constexpr size_t WS_L1 = 376 * MiB;
constexpr size_t WS_L2 = 384 * MiB;
constexpr size_t WS_ADFT = 396 * MiB;
constexpr size_t WS_X = 464 * MiB;
constexpr size_t WS_H = 600 * MiB;
constexpr size_t WS_VFIRST = 668 * MiB;
constexpr size_t WS_BSUM = 736 * MiB;
constexpr size_t WS_SCR = 744 * MiB;
constexpr size_t WS_ACT = WS_SCR + 374 * MiB, WS_HALO = WS_SCR + 562 * MiB;
constexpr size_t WS_QKV = WS_SCR, WS_T = WS_SCR + 85 * MiB, WS_MIX = WS_SCR + 119 * MiB;
constexpr size_t WS_MIXES = WS_SCR, WS_R = WS_SCR + 408 * MiB, WS_K = WS_SCR + 476 * MiB, WS_V = WS_SCR + 544 * MiB, WS_L = WS_SCR + 612 * MiB, WS_Y = WS_SCR + 646 * MiB;
constexpr size_t WS_E = WS_SCR, WS_AA = WS_SCR + 136 * MiB, WS_G = WS_SCR + 272 * MiB, WS_OA = WS_R;
constexpr size_t WS_STATS = WS_L;
constexpr size_t WS_PART = WS_SCR + 200 * MiB;
constexpr size_t WS_END = WS_SCR + 782 * MiB;
constexpr size_t MIXSZ = 68 * MiB;
constexpr int CW_BAR = 4096;
constexpr int CW_MOD = 16384;

constexpr int RING_BYTES = 131072, MISC_OFF = RING_BYTES + 320, LDS_BYTES = 147456;

#define LDS_WAIT() asm volatile("s_waitcnt lgkmcnt(0)" ::: "memory")
#define VM_WAIT() asm volatile("s_waitcnt vmcnt(0)" ::: "memory")
__device__ __forceinline__ unsigned f2bf(float f) { unsigned u = __builtin_bit_cast(unsigned, f); return (u + 0x7fffu + ((u >> 16) & 1u)) >> 16; }
__device__ __forceinline__ float bf2f(unsigned short b) { return __builtin_bit_cast(float, ((unsigned)b) << 16); }
__device__ __forceinline__ float bflo(unsigned w) { return __builtin_bit_cast(float, w << 16); }
__device__ __forceinline__ float bfhi(unsigned w) { return __builtin_bit_cast(float, w & 0xffff0000u); }
typedef float f32x2_cv __attribute__((ext_vector_type(2)));
typedef __bf16 bf16x2_cv __attribute__((ext_vector_type(2)));
__device__ __forceinline__ unsigned cvt_pk_bf16(float lo, float hi) { const f32x2_cv v = {lo, hi}; const bf16x2_cv b = __builtin_convertvector(v, bf16x2_cv); return __builtin_bit_cast(unsigned, b); }
__device__ __forceinline__ unsigned pk2(float lo, float hi) { return cvt_pk_bf16(lo, hi); }
__device__ __forceinline__ unsigned short f2h(float f) { return __builtin_bit_cast(unsigned short, (_Float16)f); }
__device__ __forceinline__ float h2f(unsigned short h) { return (float)__builtin_bit_cast(_Float16, h); }
typedef _Float16 f16x2 __attribute__((ext_vector_type(2)));
__device__ __forceinline__ float hlo(unsigned w) { return (float)__builtin_bit_cast(f16x2, w)[0]; }
__device__ __forceinline__ float hhi(unsigned w) { return (float)__builtin_bit_cast(f16x2, w)[1]; }
__device__ __forceinline__ unsigned pk2h(float a, float b) { f16x2 v; v[0] = (_Float16)a; v[1] = (_Float16)b; return __builtin_bit_cast(unsigned, v); }
__device__ __forceinline__ float sigmoidf_(float x) { return __builtin_amdgcn_rcpf(1.0f + __expf(-x)); }
__device__ __forceinline__ float tanhf_(float x) { return 1.0f - 2.0f * __builtin_amdgcn_rcpf(1.0f + __builtin_amdgcn_exp2f(x * 2.8853900817779268f)); }
__device__ __forceinline__ int opaque_s(int x) { asm volatile("" : "+s"(x)); return x; }
__device__ __forceinline__ int opaque_tid(int wave) { int l; asm volatile("v_mbcnt_lo_u32_b32 %0, -1, 0\n\tv_mbcnt_hi_u32_b32 %0, -1, %0" : "=v"(l)); return wave * 64 + l; }
template <int CTRL> __device__ __forceinline__ float dpp_mov(float x) { return __builtin_bit_cast(float, __builtin_amdgcn_update_dpp(0, __builtin_bit_cast(int, x), CTRL, 0xF, 0xF, true)); }
__device__ __forceinline__ float wave_sum(float v) {
    v += dpp_mov<0xB1>(v); v += dpp_mov<0x4E>(v); v += dpp_mov<0x141>(v); v += dpp_mov<0x140>(v);
    const int iv = __builtin_bit_cast(int, v);
    const float r0 = __builtin_bit_cast(float, __builtin_amdgcn_readlane(iv, 0)), r1 = __builtin_bit_cast(float, __builtin_amdgcn_readlane(iv, 16));
    const float r2 = __builtin_bit_cast(float, __builtin_amdgcn_readlane(iv, 32)), r3 = __builtin_bit_cast(float, __builtin_amdgcn_readlane(iv, 48));
    return (r0 + r1) + (r2 + r3);
}

#define XB_TMO      128
#define XB_XCNT(j)  (256  + 64 * (j))
#define XB_XSUB(j)  (1280 + 64 * (j))
#define XB_XGEN(j)  (2304 + 64 * (j))
#define XB_TOP      3328
#define XB_TOPGEN   3392
#define XCD_BAR_WORDS 3456
#define XB_SPIN_CAP (1u << 18)
__device__ __forceinline__ unsigned xb_ld(unsigned* p)              { return __hip_atomic_load(p, __ATOMIC_RELAXED, __HIP_MEMORY_SCOPE_AGENT); }
__device__ __forceinline__ unsigned xb_add(unsigned* p, unsigned v) { return __hip_atomic_fetch_add(p, v, __ATOMIC_RELAXED, __HIP_MEMORY_SCOPE_AGENT); }
__device__ __forceinline__ unsigned xb_xcc_id() { return (unsigned)__builtin_amdgcn_s_getreg((3 << 11) | 20) & 0xFu; }
#define XB_SPIN(cond, bar) do { unsigned _sp = 0; while (cond) { __builtin_amdgcn_s_sleep(1); \
    if ((++_sp & 255u) == 0u) { if (xb_ld(&(bar)[XB_TMO])) break; if (_sp > XB_SPIN_CAP) { atomicAdd(&(bar)[XB_TMO], 1u); break; } } } } while (0)
struct XcdBarrier { unsigned* bar; unsigned x; volatile LAS unsigned* st; int wave; };
__device__ __forceinline__ XcdBarrier xcd_barrier_post(unsigned* bar, volatile LAS unsigned* st) {
    XcdBarrier b; b.wave = 0; b.bar = bar; b.x = (unsigned)__builtin_amdgcn_readfirstlane((int)xb_xcc_id()); b.st = st;
    if (threadIdx.x == 0) (void)xb_add(&bar[XB_XCNT(b.x)], 1u);
    return b;
}
__device__ __forceinline__ void xcd_barrier_complete(unsigned* bar, unsigned x, unsigned& nloc, unsigned& nx) {
    const unsigned G = gridDim.x * gridDim.y * gridDim.z;
    unsigned sum, cnt, mine, sp = 0u;
    for (;;) {
        sum = 0u; cnt = 0u; mine = 0u;
#pragma unroll
        for (unsigned j = 0; j < 16; ++j) { const unsigned c = xb_ld(&bar[XB_XCNT(j)]); sum += c; cnt += (c > 0u) ? 1u : 0u; mine = (j == x) ? c : mine; }
        if (sum == G) break;
        __builtin_amdgcn_s_sleep(1);
        if ((++sp & 255u) == 0u) { if (xb_ld(&bar[XB_TMO])) break; if (sp > XB_SPIN_CAP) { atomicAdd(&bar[XB_TMO], 1u); break; } }
    }
    nloc = mine > 0u ? mine : 1u; nx = cnt > 0u ? cnt : 1u;
}
__device__ __forceinline__ void xcd_barrier(const XcdBarrier& b) {
    asm volatile("s_waitcnt vmcnt(0)" ::: "memory");
    __syncthreads();
    if (opaque_tid(b.wave) == 0) {
        unsigned* bar = b.bar;
        unsigned bx_ = (unsigned)__builtin_amdgcn_readfirstlane((int)xb_xcc_id()); asm volatile("" : "+s"(bx_));
        __builtin_amdgcn_s_waitcnt(0);
        unsigned nloc = b.st[0], nx = b.st[1];
        if (nloc == 0u) { xcd_barrier_complete(bar, bx_, nloc, nx); b.st[0] = nloc; b.st[1] = nx; }
        const unsigned old = xb_add(&bar[XB_XSUB(bx_)], 1u);
        const unsigned gen = old / nloc;
        if (old + 1u == (gen + 1u) * nloc) {
            __builtin_amdgcn_fence(__ATOMIC_RELEASE, "agent");
            asm volatile("s_waitcnt vmcnt(0)" ::: "memory");
            const unsigned og = xb_add(&bar[XB_TOP], 1u);
            const unsigned tg = og / nx;
            if (og + 1u == (tg + 1u) * nx) xb_add(&bar[XB_TOPGEN], 1u);
            else XB_SPIN(xb_ld(&bar[XB_TOPGEN]) == tg, bar);
            __builtin_amdgcn_fence(__ATOMIC_ACQUIRE, "agent");
            xb_add(&bar[XB_XGEN(bx_)], 1u);
            asm volatile("s_waitcnt vmcnt(0)" ::: "memory");
        } else {
            XB_SPIN(xb_ld(&bar[XB_XGEN(bx_)]) == gen, bar);
            __builtin_amdgcn_fence(__ATOMIC_ACQUIRE, "agent");
            asm volatile("s_waitcnt vmcnt(0)" ::: "memory");
        }
    }
    __syncthreads();
}

namespace pg8 {
constexpr int BM = 256, BK = 64, HALF = 128, HTB = HALF * BK * 2, STAGE_BYTES = 8 * HTB;
__device__ __forceinline__ int lds_byte(int r, int c) { const int st = (r >> 4) * 2 + (c >> 5), rr = r & 15, cc = c & 31, ob = rr * 64 + cc * 2; return st * 1024 + (ob ^ (((ob >> 9) & 1) << 5)); }
__device__ __forceinline__ void stage_rc(int b, int& R, int& C) { const int st = b / 1024, sb = b % 1024, swz = sb ^ (((sb >> 9) & 1) << 5); R = (st >> 1) * 16 + swz / 64; C = (st & 1) * 32 + (swz % 64) / 2; }
__device__ __forceinline__ int perm32(int rho) { const int n = rho >> 4, i = rho & 15; return 8 * (i >> 2) + 4 * n + (i & 3); }

struct Unit { const char* A; const char* B; int nt, pm, pn, kind; };

__device__ __forceinline__ bool tile_of(long L, int nM, int nN, int& pm, int& pn) {
    const int nwg = nM * nN; if (L >= nwg) return false;
    int wgid = (int)L; { const int q = nwg / 8, r = nwg % 8, xcd = wgid % 8, off = wgid / 8; wgid = (xcd < r ? xcd * (q + 1) : r * (q + 1) + (xcd - r) * q) + off; }
    const int nig = 8 * nN, gid = wgid / nig, fm = gid * 8, gsz = (nM - fm) < 8 ? (nM - fm) : 8;
    pm = fm + ((wgid % nig) % gsz); pn = (wgid % nig) / gsz; return true;
}

template <class Epi, class Sched>
__device__ __forceinline__ void gemm_phase(LAS unsigned char* lds, const int wave_, const int lda, const int ldb, const Sched& S, const Epi& E) {
    const int wid = opaque_s(wave_), tid = opaque_tid(wid), lane = tid & 63, wr = wid >> 2, wc = wid & 3, fr = lane & 15, fq = lane >> 4;
    unsigned voffA[2], voffB[2];
#pragma unroll
    for (int i = 0; i < 2; ++i) { int R, C; stage_rc(tid * 16 + i * 8192, R, C); const int Rb = Epi::PERM ? ((R & ~31) + perm32(R & 31)) : R;
        voffA[i] = (unsigned)(R * lda + C) * 2u; voffB[i] = (unsigned)(Rb * ldb + C) * 2u; }
    const size_t kstep = (size_t)(BK * 2);
    const size_t hstepA = (size_t)HALF * lda * 2, hstepB = (size_t)HALF * ldb * 2;
    const unsigned ldsw = (unsigned)wid * 1024u;
    const int aoff = lds_byte(wr * 64 + fr, fq * 8), boff = lds_byte(wc * 32 + fr, fq * 8);
#define PG8_SA(b, h) (((b) * 2 + (h)) * HTB)
#define PG8_SB(b, h) ((4 + (b) * 2 + (h)) * HTB)
#define PG8_STAGE(bufoff, gbase, voff) do { _Pragma("unroll") for (int _i = 0; _i < 2; ++_i) \
        __builtin_amdgcn_global_load_lds((const unsigned*)((const char*)(gbase) + (voff)[_i]), (LAS unsigned*)(lds + (bufoff) + ldsw + _i * 8192), 16, 0, 0); } while (0)
#define PG8_LDA(dst, b, h) do { _Pragma("unroll") for (int m = 0; m < 4; ++m) _Pragma("unroll") for (int k = 0; k < 2; ++k) dst[m][k] = *(const LAS bf16x8*)(lds + PG8_SA(b, h) + aoff + m * 2048 + k * 1024); } while (0)
#define PG8_LDB(dst, b, h) do { _Pragma("unroll") for (int n = 0; n < 2; ++n) _Pragma("unroll") for (int k = 0; k < 2; ++k) dst[n][k] = *(const LAS bf16x8*)(lds + PG8_SB(b, h) + boff + n * 2048 + k * 1024); } while (0)
#define PG8_MMA(ai, bj, At, Bt) do { __builtin_amdgcn_s_setprio(1); _Pragma("unroll") for (int m = 0; m < 4; ++m) _Pragma("unroll") for (int n = 0; n < 2; ++n) _Pragma("unroll") for (int k = 0; k < 2; ++k) \
        acc[ai][bj][m][n] = __builtin_amdgcn_mfma_f32_16x16x32_bf16(Bt[n][k], At[m][k], acc[ai][bj][m][n], 0, 0, 0); __builtin_amdgcn_s_setprio(0); } while (0)
#define PG8_WAIT_V(n) asm volatile("s_waitcnt vmcnt(" #n ")" ::: "memory")
#define PG8_WAIT_L(n) asm volatile("s_waitcnt lgkmcnt(" #n ")" ::: "memory")
#define PG8_BAR __builtin_amdgcn_s_barrier()
#define PG8_SCHED __builtin_amdgcn_sched_barrier(0)
    Unit cur, nxt; int ui = 0;
    if (!S.next(0, cur)) return;
    f32x4 acc[2][2][4][2];
#pragma unroll
    for (int a = 0; a < 2; ++a)
#pragma unroll
        for (int b = 0; b < 2; ++b)
#pragma unroll
            for (int m = 0; m < 4; ++m)
#pragma unroll
                for (int n = 0; n < 2; ++n) acc[a][b][m][n] = (f32x4){0.f, 0.f, 0.f, 0.f};
    bf16x8 At[4][2], B0[2][2], B1[2][2];
    const char* cA = cur.A; const char* cB = cur.B;
    PG8_STAGE(PG8_SB(0, 0), cB, voffB); PG8_STAGE(PG8_SB(0, 1), cB + hstepB, voffB); PG8_STAGE(PG8_SA(0, 0), cA, voffA); PG8_STAGE(PG8_SA(0, 1), cA + hstepA, voffA);
    if (wr == 1) PG8_BAR;
    PG8_WAIT_V(2); PG8_BAR;
    PG8_STAGE(PG8_SB(1, 0), cB + kstep, voffB); PG8_STAGE(PG8_SA(1, 0), cA + kstep, voffA); PG8_STAGE(PG8_SB(1, 1), cB + hstepB + kstep, voffB);
    PG8_WAIT_V(6); PG8_BAR;
    for (;;) {
        const bool has_next = S.next(ui + 1, nxt);
        const char* nA = has_next ? nxt.A : cA; const char* nB = has_next ? nxt.B : cB;
        const int nt = opaque_s(cur.nt);
        for (int t = 0; t < nt; t += 2) {
            const bool last = (t == nt - 2);
            const char* a1 = cA + (size_t)(t + 1) * kstep;
            const char* a2 = last ? nA : cA + (size_t)(t + 2) * kstep; const char* b2 = last ? nB : cB + (size_t)(t + 2) * kstep;
            const char* a3 = a2 + kstep; const char* b3 = b2 + kstep;
            PG8_LDB(B0, 0, 0); PG8_LDB(B1, 0, 1); PG8_SCHED; PG8_LDA(At, 0, 0); PG8_STAGE(PG8_SA(1, 1), a1 + hstepA, voffA);
            PG8_WAIT_V(8); PG8_WAIT_L(0); PG8_BAR; PG8_MMA(0, 0, At, B0); PG8_MMA(0, 1, At, B1); PG8_BAR; PG8_SCHED;
            PG8_LDA(At, 0, 1); PG8_STAGE(PG8_SB(0, 0), b2, voffB); PG8_STAGE(PG8_SB(0, 1), b2 + hstepB, voffB); PG8_STAGE(PG8_SA(0, 0), a2, voffA);
            PG8_WAIT_V(8); PG8_WAIT_L(0); PG8_BAR; PG8_MMA(1, 0, At, B0); PG8_MMA(1, 1, At, B1); PG8_BAR; PG8_SCHED;
            PG8_LDB(B0, 1, 0); PG8_LDB(B1, 1, 1); PG8_SCHED; PG8_LDA(At, 1, 0); PG8_STAGE(PG8_SA(0, 1), a2 + hstepA, voffA);
            PG8_WAIT_V(8); PG8_WAIT_L(0); PG8_BAR; PG8_MMA(0, 0, At, B0); PG8_MMA(0, 1, At, B1); PG8_BAR; PG8_SCHED;
            PG8_LDA(At, 1, 1); PG8_STAGE(PG8_SB(1, 0), b3, voffB); PG8_STAGE(PG8_SB(1, 1), b3 + hstepB, voffB); PG8_STAGE(PG8_SA(1, 0), a3, voffA);
            PG8_WAIT_V(8); PG8_WAIT_L(0); PG8_BAR; PG8_MMA(1, 0, At, B0); PG8_MMA(1, 1, At, B1); PG8_BAR; PG8_SCHED;
        }
        if (wr == 0) PG8_BAR;
        E(acc, cur, wr, wc, fr, fq);
        if (!has_next) break;
#pragma unroll
        for (int a = 0; a < 2; ++a)
#pragma unroll
            for (int b = 0; b < 2; ++b)
#pragma unroll
                for (int m = 0; m < 4; ++m)
#pragma unroll
                    for (int n = 0; n < 2; ++n) acc[a][b][m][n] = (f32x4){0.f, 0.f, 0.f, 0.f};
        cur = nxt; cA = nA; cB = nB; ++ui;
        if (wr == 1) PG8_BAR;
    }
    PG8_WAIT_V(0);
    PG8_BAR;
#undef PG8_SA
#undef PG8_SB
#undef PG8_STAGE
#undef PG8_LDA
#undef PG8_LDB
#undef PG8_MMA
#undef PG8_WAIT_V
#undef PG8_WAIT_L
#undef PG8_BAR
#undef PG8_SCHED
}

struct SchedSimple {
    const char* A; const char* B; size_t astep, bstep; int nM, nN, nt, G, c;
    __device__ __forceinline__ bool next(int i, Unit& u) const {
        int pm, pn; if (!tile_of((long)i * G + c, nM, nN, pm, pn)) return false;
        if (nM == 64) pm = (pm >> 4) * PPB + 1 + (pm & 15);
        u.A = A + (size_t)pm * astep; u.B = B + (size_t)pn * bstep; u.nt = nt; u.pm = pm; u.pn = pn; u.kind = 0; return true; }
};
struct SchedRes {
    const char* A; const char* B; size_t astep, bstep; int nt, lat_only, G, c;
    __device__ __forceinline__ bool next(int i, Unit& u) const {
        const long L = (long)i * G + c;
        if (L < 512) { int pl, pn; tile_of(L, 64, 8, pl, pn); const int pm = (pl >> 4) * PPB + 1 + (pl & 15);
            u.A = A + (size_t)pm * astep; u.B = B + (size_t)pn * bstep; u.nt = nt; u.pm = pm; u.pn = pn; u.kind = 0; return true; }
        if (lat_only || L >= 768) return false;
        const int s = (int)L - 512, sl = s >> 5, cu = s & 31, b = cu >> 3, pn = cu & 7, pm = b * PPB;
        int t0, n;
        if (nt == 32) { t0 = 4 * sl; n = 4; } else { t0 = (sl < 4) ? 12 * sl : 48 + 10 * (sl - 4); n = (sl < 4) ? 12 : 10; }
        u.A = A + (size_t)pm * astep + (size_t)t0 * 128; u.B = B + (size_t)pn * bstep + (size_t)t0 * 128; u.nt = n; u.pm = pm; u.pn = pn; u.kind = 1 + sl; return true; }
};
struct SchedInproj {
    const char* H; const char* Wqkv; const char* Wpq; int G, c;
    __device__ __forceinline__ bool next(int i, Unit& u) const {
        int tp, ft; if (!tile_of((long)i * G + c, NPAN, 14, tp, ft)) return false;
        const size_t st = (size_t)256 * 2048 * 2; u.nt = 32;
        if (ft < 10) { u.A = H + tp * st; u.B = Wqkv + ft * st; u.pm = tp; u.pn = ft; u.kind = 0; }
        else { u.A = Wpq + (ft - 10) * st; u.B = H + tp * st; u.pm = ft - 10; u.pn = tp; u.kind = 1; }
        return true; }
};
struct SchedDft {
    const char* ADFT; const char* T; int G, c;
    __device__ __forceinline__ bool next(int i, Unit& u) const {
        int idx;
        if (G == 256) { if (i == 0 && c < 128) idx = c; else if (i == 1 && c < 8) idx = 128 + c; else return false; }
        else { const long L = (long)i * G + c; if (L >= 136) return false; idx = (int)L; }
        u.kind = 0;
        if (idx < 128) { const int b = idx >> 5, r = idx & 31, k1t = r >> 1, ct = r & 1;
            u.A = ADFT + (size_t)k1t * 256 * 8192 * 2; u.B = T + ((size_t)(b * 512 + ct * 256) * TLD + 512) * 2; u.nt = 128; u.pm = b * PPB + 1 + k1t; u.pn = 6 + ct; }
        else { const int cc = idx - 128, b = cc >> 1, ct = cc & 1;
            u.A = ADFT + (size_t)4096 * 8192 * 2; u.B = T + ((size_t)(b * 512 + ct * 256) * TLD) * 2; u.nt = 8; u.pm = b * PPB; u.pn = 6 + ct; }
        return true; }
};
struct SchedRkvl {
    const char* MIXES; const char* W; const char* L1; int G, c;
    __device__ __forceinline__ bool next(int i, Unit& u) const {
        int tp, ft; if (!tile_of((long)i * G + c, NPAN, 28, tp, ft)) return false;
        const size_t st = (size_t)256 * 2048 * 2; u.nt = 32; u.pm = tp;
        int mix;
        if (ft < 24) { const int which = ft >> 3; mix = (which == 0) ? 0 : (which == 1 ? 2 : 3); u.B = W + (size_t)which * 8 * MiB + (size_t)(ft & 7) * st; u.pn = ft & 7; u.kind = which; }
        else { const int q = ft - 24; mix = (q == 0) ? 1 : (q == 1 ? 4 : (q == 2 ? 5 : 3)); u.B = L1 + (size_t)q * st; u.pn = q; u.kind = 3; }
        u.A = MIXES + (size_t)mix * MIXSZ + tp * st;
        return true; }
};
struct SchedLora2 {
    const char* L; const char* W2; int nN, G, c;
    __device__ __forceinline__ bool next(int i, Unit& u) const {
        int tp, ft; if (!tile_of((long)i * G + c, NPAN, nN, tp, ft)) return false;
        const size_t bst = (size_t)256 * 256 * 2; u.nt = 4; u.pm = tp;
        int kind, pn; size_t wb;
        if (ft < 16) { kind = 0; pn = ft; wb = 0; } else if (ft < 32) { kind = 1; pn = ft - 16; wb = 2 * MiB; } else if (ft < 40) { kind = 2; pn = ft - 32; wb = 4 * MiB; } else { kind = 3; pn = ft - 40; wb = 5 * MiB; }
        u.A = L + (size_t)tp * 256 * 1024 * 2 + (size_t)kind * 512; u.B = W2 + wb + (size_t)pn * bst; u.pn = pn; u.kind = kind;
        if (kind != 2) { u.nt = 2; if (kind < 2 && pn >= 8) { u.A += 256; u.B += 256; } }
        return true; }
};

struct EpiStore {
    static constexpr bool PERM = true;
    bf16* O; int ldo;
    __device__ __forceinline__ void operator()(const f32x4 (&acc)[2][2][4][2], const Unit& u, int wr, int wc, int fr, int fq) const {
        const int row0 = u.pm * BM + wr * 64 + fr, col0 = u.pn * BM + wc * 32 + 8 * fq;
#pragma unroll
        for (int ai = 0; ai < 2; ++ai)
#pragma unroll
            for (int m = 0; m < 4; ++m) { bf16* rowp = O + (size_t)(row0 + ai * HALF + m * 16) * ldo + col0;
#pragma unroll
                for (int bj = 0; bj < 2; ++bj) { const f32x4 v0 = acc[ai][bj][m][0], v1 = acc[ai][bj][m][1];
                    u32x4 w; w.x = cvt_pk_bf16(v0[0], v0[1]); w.y = cvt_pk_bf16(v0[2], v0[3]); w.z = cvt_pk_bf16(v1[0], v1[1]); w.w = cvt_pk_bf16(v1[2], v1[3]);
                    *(u32x4*)(rowp + bj * HALF) = w; } }
    }
};
template <int CTRL> __device__ __forceinline__ f32x4 dpp4(const f32x4 x) { f32x4 r;
#pragma unroll
    for (int e = 0; e < 4; ++e) { const float xe = x[e]; r[e] = __int_as_float(__builtin_amdgcn_update_dpp(0, __float_as_int(xe), CTRL, 0xF, 0xF, true)); }
    return r; }
struct EpiUpConv {
    static constexpr bool PERM = false;
    bf16* ACT; bf16* HALO; const float* cw; const float* cb; LAS unsigned char* ex;
    __device__ __forceinline__ void operator()(const f32x4 (&acc)[2][2][4][2], const Unit& u, int wr, int wc, int fr, int fq) const {
        const int colb = wc * 32 + 4 * fq;
        LAS float* EX = (LAS float*)ex;
#pragma unroll
        for (int ai = 0; ai < 2; ++ai) { const int blk = 2 * ai + wr;
#pragma unroll
            for (int bj = 0; bj < 2; ++bj) {
                const bool top = (fr == 0);
                f32x4 e0, e1;
#pragma unroll
                for (int e = 0; e < 4; ++e) { e0[e] = top ? acc[ai][bj][0][0][e] : acc[ai][bj][3][0][e]; e1[e] = top ? acc[ai][bj][0][1][e] : acc[ai][bj][3][1][e]; }
                if (fr == 0 || fr == 15) { LAS float* p = EX + ((blk * 2 + (top ? 0 : 1)) * 256 + bj * HALF + colb); *(LAS f32x4*)p = e0; *(LAS f32x4*)(p + 16) = e1; }
            } }
        if (wr == 0 && fr < 2) {
#pragma unroll
            for (int bj = 0; bj < 2; ++bj) { const f32x4 v0 = acc[0][bj][0][0], v1 = acc[0][bj][0][1];
                u32x2 w0, w1; w0.x = cvt_pk_bf16(v0[0], v0[1]); w0.y = cvt_pk_bf16(v0[2], v0[3]); w1.x = cvt_pk_bf16(v1[0], v1[1]); w1.y = cvt_pk_bf16(v1[2], v1[3]);
                bf16* hp = HALO + ((size_t)u.pm * 4 + fr) * DFF2 + u.pn * 256 + bj * HALF + colb; *(u32x2*)hp = w0; *(u32x2*)(hp + 16) = w1; } }
        if (wr == 1 && fr >= 14) {
#pragma unroll
            for (int bj = 0; bj < 2; ++bj) { const f32x4 v0 = acc[1][bj][3][0], v1 = acc[1][bj][3][1];
                u32x2 w0, w1; w0.x = cvt_pk_bf16(v0[0], v0[1]); w0.y = cvt_pk_bf16(v0[2], v0[3]); w1.x = cvt_pk_bf16(v1[0], v1[1]); w1.y = cvt_pk_bf16(v1[2], v1[3]);
                bf16* hp = HALO + ((size_t)u.pm * 4 + (fr - 12)) * DFF2 + u.pn * 256 + bj * HALF + colb; *(u32x2*)hp = w0; *(u32x2*)(hp + 16) = w1; } }
        asm volatile("s_waitcnt lgkmcnt(0)" ::: "memory"); __builtin_amdgcn_s_barrier(); asm volatile("" ::: "memory");
        const int row0 = u.pm * BM + wr * 64 + fr;
#pragma unroll
        for (int n = 0; n < 2; ++n) {
            const int ch = u.pn * 128 + colb + 16 * n;
            const f32x4 wg0 = *(const f32x4*)(cw + ch), wg1 = *(const f32x4*)(cw + DFF2 + ch), wg2 = *(const f32x4*)(cw + 2 * DFF2 + ch), bg = *(const f32x4*)(cb + ch);
            const f32x4 wv0 = *(const f32x4*)(cw + DFF + ch), wv1 = *(const f32x4*)(cw + DFF2 + DFF + ch), wv2 = *(const f32x4*)(cw + 2 * DFF2 + DFF + ch), bv = *(const f32x4*)(cb + DFF + ch);
#pragma unroll
            for (int ai = 0; ai < 2; ++ai) { const int blk = 2 * ai + wr;
                const f32x4 z4 = (f32x4){0.f, 0.f, 0.f, 0.f};
                f32x4 xug = z4, xuv = z4, xdg = z4, xdv = z4;
                if (blk > 0) { xug = *(const LAS f32x4*)(EX + (((blk - 1) * 2 + 1) * 256 + colb + 16 * n)); xuv = *(const LAS f32x4*)(EX + (((blk - 1) * 2 + 1) * 256 + HALF + colb + 16 * n)); }
                if (blk < 3) { xdg = *(const LAS f32x4*)(EX + (((blk + 1) * 2 + 0) * 256 + colb + 16 * n)); xdv = *(const LAS f32x4*)(EX + (((blk + 1) * 2 + 0) * 256 + HALF + colb + 16 * n)); }
                u32x2 wm[4];
#pragma unroll
                for (int m = 0; m < 4; ++m) {
                    const f32x4 g = acc[ai][0][m][n], v = acc[ai][1][m][n];
                    const f32x4 gp = (m > 0) ? acc[ai][0][m > 0 ? m - 1 : 0][n] : xug, gn = (m < 3) ? acc[ai][0][m < 3 ? m + 1 : 3][n] : xdg;
                    const f32x4 vp = (m > 0) ? acc[ai][1][m > 0 ? m - 1 : 0][n] : xuv, vn = (m < 3) ? acc[ai][1][m < 3 ? m + 1 : 3][n] : xdv;
                    const f32x4 ug = dpp4<0x121>(fr == 15 ? gp : g), dg = dpp4<0x12F>(fr == 0 ? gn : g);
                    const f32x4 uv = dpp4<0x121>(fr == 15 ? vp : v), dv = dpp4<0x12F>(fr == 0 ? vn : v);
                    const f32x4 pg = bg + wg0 * ug + wg1 * g + wg2 * dg, pv = bv + wv0 * uv + wv1 * v + wv2 * dv;
                    float o[4];
#pragma unroll
                    for (int e = 0; e < 4; ++e) o[e] = pg[e] * sigmoidf_(pg[e]) * pv[e];
                    wm[m].x = cvt_pk_bf16(o[0], o[1]); wm[m].y = cvt_pk_bf16(o[2], o[3]);
                    if (m & 1) {
                        const auto rx = __builtin_amdgcn_permlane16_swap(wm[m - 1].x, wm[m].x, false, false), ry = __builtin_amdgcn_permlane16_swap(wm[m - 1].y, wm[m].y, false, false);
                        u32x4 w4; w4.x = rx[0]; w4.y = ry[0]; w4.z = rx[1]; w4.w = ry[1];
                        *(u32x4*)(ACT + (size_t)(row0 + ai * HALF + (m - 1 + (fq & 1)) * 16) * DFF + ch - 4 * (fq & 1)) = w4; }
                } }
        }
    }
};
struct EpiInproj {
    static constexpr bool PERM = true;
    bf16* QKV; bf16* T; const float* qg; const float* kg; const float* RC; const float* RS; LAS unsigned char* ex;
    __device__ __forceinline__ void operator()(const f32x4 (&acc)[2][2][4][2], const Unit& u, int wr, int wc, int fr, int fq) const {
        if (u.kind == 0) {
            if (u.pn >= 8) { EpiStore e{QKV, NQKV}; e(acc, u, wr, wc, fr, fq); return; }
            LAS float* EX = (LAS float*)ex;
            const float* gain = (u.pn < 6) ? qg : kg;
            const int b = u.pm / PPB, tile = u.pm % PPB, colb = wc * 32 + 8 * fq;
#pragma unroll
            for (int ai = 0; ai < 2; ++ai)
#pragma unroll
                for (int m = 0; m < 4; ++m)
#pragma unroll
                    for (int bj = 0; bj < 2; ++bj) { const f32x4 v0 = acc[ai][bj][m][0], v1 = acc[ai][bj][m][1];
                        float ss = (v0[0] * v0[0] + v0[1] * v0[1]) + (v0[2] * v0[2] + v0[3] * v0[3]) + (v1[0] * v1[0] + v1[1] * v1[1]) + (v1[2] * v1[2] + v1[3] * v1[3]);
                        ss += __shfl_xor(ss, 16); ss += __shfl_xor(ss, 32);
                        if (fq == 0) EX[((ai * HALF + wr * 64 + m * 16 + fr) * 2 + bj) * 4 + wc] = ss; }
            asm volatile("s_waitcnt lgkmcnt(0)" ::: "memory"); __builtin_amdgcn_s_barrier(); asm volatile("" ::: "memory");
            const int row0 = u.pm * BM + wr * 64 + fr;
#pragma unroll
            for (int bj = 0; bj < 2; ++bj) {
                const f32x4 g0 = *(const f32x4*)(gain + colb), g1 = *(const f32x4*)(gain + colb + 4);
#pragma unroll
                for (int ai = 0; ai < 2; ++ai)
#pragma unroll
                    for (int m = 0; m < 4; ++m) { const int rl = ai * HALF + wr * 64 + m * 16 + fr;
                        const f32x4 p4 = *(const LAS f32x4*)(EX + (rl * 2 + bj) * 4);
                        const float rstd = rsqrtf(((p4[0] + p4[1]) + (p4[2] + p4[3])) * (1.0f / 128.0f) + 1e-6f);
                        float x[8];
#pragma unroll
                        for (int e = 0; e < 4; ++e) { x[e] = acc[ai][bj][m][0][e] * rstd * g0[e]; x[4 + e] = acc[ai][bj][m][1][e] * rstd * g1[e]; }
                        if (tile != 0) { const int t = (tile - 1) * 256 + rl;
                            const f32x4 cc = *(const f32x4*)(RC + (size_t)t * 64 + (colb >> 1)), sn = *(const f32x4*)(RS + (size_t)t * 64 + (colb >> 1));
#pragma unroll
                            for (int p = 0; p < 4; ++p) { const float x0 = x[2 * p], x1 = x[2 * p + 1]; x[2 * p] = x0 * cc[p] - x1 * sn[p]; x[2 * p + 1] = x0 * sn[p] + x1 * cc[p]; } }
                        u32x4 w; w.x = cvt_pk_bf16(x[0], x[1]); w.y = cvt_pk_bf16(x[2], x[3]); w.z = cvt_pk_bf16(x[4], x[5]); w.w = cvt_pk_bf16(x[6], x[7]);
                        *(u32x4*)(QKV + (size_t)(row0 + ai * HALF + m * 16) * NQKV + u.pn * BM + bj * HALF + colb) = w; }
            }
            (void)b;
            return; }
        const int b = u.pn / PPB, tile = u.pn % PPB;
        const int j0 = u.pm * BM + wr * 64 + fr, cc0 = wc * 32 + 8 * fq;
#pragma unroll
        for (int ai = 0; ai < 2; ++ai)
#pragma unroll
            for (int m = 0; m < 4; ++m) { const int j = j0 + ai * HALF + m * 16, pq = j >> 9, gk = j & 511;
                const int off = (tile == 0) ? (pq * 256 + cc0) : (512 + pq * 4096 + (tile - 1) * 256 + cc0);
                bf16* rowp = T + (size_t)(b * 512 + gk) * TLD + off;
#pragma unroll
                for (int bj = 0; bj < 2; ++bj) { const f32x4 v0 = acc[ai][bj][m][0], v1 = acc[ai][bj][m][1];
                    u32x4 w; w.x = cvt_pk_bf16(v0[0], v0[1]); w.y = cvt_pk_bf16(v0[2], v0[3]); w.z = cvt_pk_bf16(v1[0], v1[1]); w.w = cvt_pk_bf16(v1[2], v1[3]);
                    *(u32x4*)(rowp + bj * HALF) = w; } }
    }
};
struct EpiResid {
    static constexpr bool PERM = true;
    bf16* X; const float* gate; unsigned short* PART;
    __device__ __forceinline__ void operator()(const f32x4 (&acc)[2][2][4][2], const Unit& u, int wr, int wc, int fr, int fq) const {
        const int b = u.pm / PPB, tile = u.pm % PPB, rc = (tile == 0) ? 4 : b;
        const int row0 = u.pm * BM + wr * 64 + fr, col0 = u.pn * BM + wc * 32 + 8 * fq;
        if (u.kind > 0) {
            unsigned short* pb = PART + ((size_t)(u.kind - 1) * 1024 + (size_t)b * 256 + wr * 64 + fr) * DM + col0;
#pragma unroll
            for (int ai = 0; ai < 2; ++ai)
#pragma unroll
                for (int m = 0; m < 4; ++m)
#pragma unroll
                    for (int bj = 0; bj < 2; ++bj) { const f32x4 v0 = acc[ai][bj][m][0], v1 = acc[ai][bj][m][1];
                        u32x4 w; w.x = pk2h(v0[0], v0[1]); w.y = pk2h(v0[2], v0[3]); w.z = pk2h(v1[0], v1[1]); w.w = pk2h(v1[2], v1[3]);
                        *(u32x4*)(pb + (size_t)(ai * HALF + m * 16) * DM + bj * HALF) = w; }
            return; }
        const float* gp = gate + (size_t)rc * 12288 + col0;
        f32x4 gv[2][2];
#pragma unroll
        for (int bj = 0; bj < 2; ++bj)
#pragma unroll
            for (int n = 0; n < 2; ++n) gv[bj][n] = *(const f32x4*)(gp + bj * HALF + n * 4);
        u32x4 xv[2][4][2];
#pragma unroll
        for (int ai = 0; ai < 2; ++ai)
#pragma unroll
            for (int m = 0; m < 4; ++m)
#pragma unroll
                for (int bj = 0; bj < 2; ++bj) xv[ai][m][bj] = *(const u32x4*)(X + (size_t)(row0 + ai * HALF + m * 16) * DM + col0 + bj * HALF);
#pragma unroll
        for (int ai = 0; ai < 2; ++ai)
#pragma unroll
            for (int m = 0; m < 4; ++m)
#pragma unroll
                for (int bj = 0; bj < 2; ++bj) { const u32x4 x4 = xv[ai][m][bj];
                    const f32x4 a0 = gv[bj][0] * acc[ai][bj][m][0], a1 = gv[bj][1] * acc[ai][bj][m][1];
                    u32x4 w; w.x = pk2h(hlo(x4.x) + a0[0], hhi(x4.x) + a0[1]); w.y = pk2h(hlo(x4.y) + a0[2], hhi(x4.y) + a0[3]);
                    w.z = pk2h(hlo(x4.z) + a1[0], hhi(x4.z) + a1[1]); w.w = pk2h(hlo(x4.w) + a1[2], hhi(x4.w) + a1[3]);
                    *(u32x4*)(X + (size_t)(row0 + ai * HALF + m * 16) * DM + col0 + bj * HALF) = w; }
    }
};
struct EpiRkvl {
    static constexpr bool PERM = true;
    bf16* R; bf16* K; bf16* V; bf16* L;
    __device__ __forceinline__ void operator()(const f32x4 (&acc)[2][2][4][2], const Unit& u, int wr, int wc, int fr, int fq) const {
        if (u.kind < 3) { EpiStore e{u.kind == 0 ? R : (u.kind == 1 ? K : V), DM}; e(acc, u, wr, wc, fr, fq); return; }
        const int row0 = u.pm * BM + wr * 64 + fr, col0 = u.pn * BM + wc * 32 + 8 * fq, act = u.pn;
#pragma unroll
        for (int ai = 0; ai < 2; ++ai)
#pragma unroll
            for (int m = 0; m < 4; ++m) { bf16* rowp = L + (size_t)(row0 + ai * HALF + m * 16) * 1024 + col0;
#pragma unroll
                for (int bj = 0; bj < 2; ++bj) { float v[8];
#pragma unroll
                    for (int e = 0; e < 4; ++e) { v[e] = acc[ai][bj][m][0][e]; v[4 + e] = acc[ai][bj][m][1][e]; }
                    if (act == 0) {
#pragma unroll
                        for (int e = 0; e < 8; ++e) v[e] = tanhf_(v[e]);
                    } else if (act == 2) {
#pragma unroll
                        for (int e = 0; e < 8; ++e) v[e] = sigmoidf_(v[e]);
                    }
                    u32x4 w; w.x = cvt_pk_bf16(v[0], v[1]); w.y = cvt_pk_bf16(v[2], v[3]); w.z = cvt_pk_bf16(v[4], v[5]); w.w = cvt_pk_bf16(v[6], v[7]);
                    *(u32x4*)(rowp + bj * HALF) = w; } }
    }
};
struct EpiLora2 {
    static constexpr bool PERM = true;
    unsigned short* E; unsigned short* AA; bf16* Gg; bf16* V; const bf16* VF; const float* w0; const float* a0; const float* v0;
    __device__ __forceinline__ void operator()(const f32x4 (&acc)[2][2][4][2], const Unit& u, int wr, int wc, int fr, int fq) const {
        const int row0 = u.pm * BM + wr * 64 + fr, col0 = u.pn * BM + wc * 32 + 8 * fq, kind = u.kind;
        float bias[2][8];
#pragma unroll
        for (int bj = 0; bj < 2; ++bj)
#pragma unroll
            for (int e = 0; e < 8; ++e) { const int c = col0 + bj * HALF + e; bias[bj][e] = (kind == 0) ? w0[c] : (kind == 1 ? a0[c] : (kind == 3 ? v0[c] : 0.f)); }
#pragma unroll
        for (int ai = 0; ai < 2; ++ai)
#pragma unroll
            for (int m = 0; m < 4; ++m) { const size_t row = (size_t)(row0 + ai * HALF + m * 16);
#pragma unroll
                for (int bj = 0; bj < 2; ++bj) { float v[8];
#pragma unroll
                    for (int e = 0; e < 4; ++e) { v[e] = acc[ai][bj][m][0][e] + bias[bj][e]; v[4 + e] = acc[ai][bj][m][1][e] + bias[bj][4 + e]; }
                    const int c = col0 + bj * HALF;
                    if (kind == 0 || kind == 1) {
                        const float isc = (kind == 0) ? 1.6487212707f : 1.0f;
                        u32x4 w; unsigned short hh[8];
#pragma unroll
                        for (int e = 0; e < 8; ++e) hh[e] = f2h(__builtin_amdgcn_rcpf(fmaf(__builtin_amdgcn_exp2f(v[e] * -1.4426950408889634f), isc, isc)));
                        w.x = hh[0] | ((unsigned)hh[1] << 16); w.y = hh[2] | ((unsigned)hh[3] << 16); w.z = hh[4] | ((unsigned)hh[5] << 16); w.w = hh[6] | ((unsigned)hh[7] << 16);
                        *(u32x4*)((kind == 0 ? E : AA) + row * 4096 + c) = w;
                    } else if (kind == 2) {
                        u32x4 w; w.x = cvt_pk_bf16(v[0], v[1]); w.y = cvt_pk_bf16(v[2], v[3]); w.z = cvt_pk_bf16(v[4], v[5]); w.w = cvt_pk_bf16(v[6], v[7]);
                        *(u32x4*)(Gg + row * DM + c) = w;
                    } else {
                        const u32x4 vv = *(const u32x4*)(V + row * DM + c), vf = *(const u32x4*)(VF + row * DM + c);
                        float o[8];
#pragma unroll
                        for (int q = 0; q < 4; ++q) { const float a0_ = bflo(vv[q]), a1_ = bfhi(vv[q]), f0 = bflo(vf[q]), f1 = bfhi(vf[q]);
                            o[2 * q] = a0_ + (f0 - a0_) * sigmoidf_(v[2 * q]); o[2 * q + 1] = a1_ + (f1 - a1_) * sigmoidf_(v[2 * q + 1]); }
                        u32x4 w; w.x = cvt_pk_bf16(o[0], o[1]); w.y = cvt_pk_bf16(o[2], o[3]); w.z = cvt_pk_bf16(o[4], o[5]); w.w = cvt_pk_bf16(o[6], o[7]);
                        *(u32x4*)(V + row * DM + c) = w;
                    } } }
    }
};
}

namespace att {
constexpr int D = 128, NW = 8, QBLK = 32, KVBLK = 64;
constexpr float SCALE = 0.088388347648318440f;
constexpr float THR = 8.f;
constexpr int LDQ = NQKV, LDK = NQKV, LDO = DM;
constexpr size_t SHM_V = KVBLK * D * 2, SHM_K = KVBLK * D * 2, SHM_ATTN = 2 * SHM_V + 2 * SHM_K + NW * 64 * 4;
#define KSWZ(row, colB) ((row) * 256 + ((colB) ^ (((row) & 7) << 4)))
#define SBAR() __builtin_amdgcn_sched_barrier(0)
__device__ __forceinline__ int crow(int r, int hi) { return (r & 3) + 8 * (r >> 2) + 4 * hi; }
__device__ __forceinline__ unsigned cvtpk(float lo, float hi) { unsigned r; asm volatile("v_cvt_pk_bf16_f32 %0, %1, %2" : "=v"(r) : "v"(lo), "v"(hi)); return r; }
__device__ __forceinline__ void partialSM(f32x16& p0, f32x16& p1, float& m_reg, float& mn, float& alpha) {
  constexpr float C = SCALE * 1.4426950408889634f;
  float pmax = p0[0]; for (int r = 1; r < 16; ++r) pmax = fmaxf(pmax, p0[r]); for (int r = 0; r < 16; ++r) pmax = fmaxf(pmax, p1[r]);
  { auto rr = __builtin_amdgcn_permlane32_swap(__float_as_uint(pmax), __float_as_uint(pmax), false, false);
    pmax = fmaxf(__uint_as_float(rr[0]), __uint_as_float(rr[1])); }
  if (__builtin_expect(__all(pmax - m_reg <= THR / SCALE), 1)) { mn = m_reg; alpha = 1.f; }
  else { mn = fmaxf(m_reg, pmax); alpha = __builtin_amdgcn_exp2f((m_reg - mn) * C); m_reg = mn; }
  float mnC = -mn * C;
  { const f32x2_cv C2 = {C, C}, M2 = {mnC, mnC};
    for (int r = 0; r < 8; ++r) { f32x2_cv t = {p0[2 * r], p0[2 * r + 1]}; t = t * C2 + M2; p0[2 * r] = t[0]; p0[2 * r + 1] = t[1]; }
    for (int r = 0; r < 8; ++r) { f32x2_cv t = {p1[2 * r], p1[2 * r + 1]}; t = t * C2 + M2; p1[2 * r] = t[0]; p1[2 * r + 1] = t[1]; } }
  for (int r = 0; r < 16; ++r) p0[r] = __builtin_amdgcn_exp2f(p0[r]);
}
__device__ __forceinline__ void finishSM(f32x16& p0, f32x16& p1, float alpha, float& l_reg, bf16x8& pa0, bf16x8& pa1, bf16x8& pa2, bf16x8& pa3) {
  for (int r = 0; r < 16; ++r) p1[r] = __builtin_amdgcn_exp2f(p1[r]);
  float ps;
  { f32x2_cv s2 = {0.f, 0.f}, s3 = {0.f, 0.f};
    for (int r = 0; r < 8; ++r) { s2 += (f32x2_cv){p0[2 * r], p0[2 * r + 1]}; s3 += (f32x2_cv){p1[2 * r], p1[2 * r + 1]}; }
    s2 += s3; ps = s2[0] + s2[1]; }
  { auto rr = __builtin_amdgcn_permlane32_swap(__float_as_uint(ps), __float_as_uint(ps), false, false);
    ps = __uint_as_float(rr[0]) + __uint_as_float(rr[1]); }
  l_reg = l_reg * alpha + ps;
#define PK4(P, BASE, OUT) do { unsigned a0 = cvtpk(P[BASE + 0], P[BASE + 1]), a1 = cvtpk(P[BASE + 2], P[BASE + 3]);   \
    unsigned b0 = cvtpk(P[BASE + 4], P[BASE + 5]), b1 = cvtpk(P[BASE + 6], P[BASE + 7]);                              \
    auto r0 = __builtin_amdgcn_permlane32_swap(a0, b0, false, false); auto r1 = __builtin_amdgcn_permlane32_swap(a1, b1, false, false); \
    u32x4 w = {r0[0], r1[0], r0[1], r1[1]}; OUT = *reinterpret_cast<bf16x8*>(&w); } while (0)
  PK4(p0, 0, pa0); PK4(p0, 8, pa1); PK4(p1, 0, pa2); PK4(p1, 8, pa3);
#undef PK4
}
__device__ __forceinline__ void qkt(f32x16& p0, f32x16& p1, const bf16* Ks, const bf16x8* qr, int r32, int hi) {
  p0 = f32x16{}; p1 = f32x16{};
  for (int d0 = 0; d0 < 8; ++d0) { int cb = (d0 * 16 + hi * 8) * 2;
    bf16x8 b0 = *reinterpret_cast<const bf16x8*>((const char*)Ks + KSWZ(r32, cb));
    bf16x8 b1 = *reinterpret_cast<const bf16x8*>((const char*)Ks + KSWZ(32 + r32, cb));
    p0 = __builtin_amdgcn_mfma_f32_32x32x16_bf16(b0, qr[d0], p0, 0, 0, 0);
    p1 = __builtin_amdgcn_mfma_f32_32x32x16_bf16(b1, qr[d0], p1, 0, 0, 0); }
}
__device__ __forceinline__ int v_st(int k, int c) { const int kk = (k & ~0xC) | ((k & 4) << 1) | ((k & 8) >> 1); return ((kk >> 3) * 4 + (c >> 5)) * 512 + ((kk & 7) * 32 + (c & 31)) * 2; }
__device__ __forceinline__ int v_rd_base(int lane) { return ((lane & 3) << 3) | (((lane >> 2) & 3) << 6) | (((lane >> 4) & 1) << 5) | (((lane >> 5) & 1) << 8); }
constexpr int v_rd_off(int d0, int ks, int half) { return d0 * 512 + ks * 4096 + half * 2048; }
template <int OFF> __device__ __forceinline__ s16x4 tr_read(int vb) {
  s16x4 r; asm volatile("ds_read_b64_tr_b16 %0, %1 offset:%2" : "=&v"(r) : "v"(vb), "i"(OFF) : "memory"); return r;
}
template <int D0> __device__ __forceinline__ void pv_one(f32x16& od, int vb, bf16x8 pa0, bf16x8 pa1, bf16x8 pa2, bf16x8 pa3) {
  const s16x4 l0 = tr_read<v_rd_off(D0, 0, 0)>(vb), h0 = tr_read<v_rd_off(D0, 0, 1)>(vb), l1 = tr_read<v_rd_off(D0, 1, 0)>(vb), h1 = tr_read<v_rd_off(D0, 1, 1)>(vb);
  const s16x4 l2 = tr_read<v_rd_off(D0, 2, 0)>(vb), h2 = tr_read<v_rd_off(D0, 2, 1)>(vb), l3 = tr_read<v_rd_off(D0, 3, 0)>(vb), h3 = tr_read<v_rd_off(D0, 3, 1)>(vb);
  asm volatile("s_waitcnt lgkmcnt(0)" ::: "memory"); SBAR();
#define PK(L, H) (bf16x8){L[0], L[1], L[2], L[3], H[0], H[1], H[2], H[3]}
  od = __builtin_amdgcn_mfma_f32_32x32x16_bf16(pa0, PK(l0, h0), od, 0, 0, 0);
  od = __builtin_amdgcn_mfma_f32_32x32x16_bf16(pa1, PK(l1, h1), od, 0, 0, 0);
  od = __builtin_amdgcn_mfma_f32_32x32x16_bf16(pa2, PK(l2, h2), od, 0, 0, 0);
  od = __builtin_amdgcn_mfma_f32_32x32x16_bf16(pa3, PK(l3, h3), od, 0, 0, 0);
#undef PK
}
__device__ __forceinline__ void pv_d0(f32x16* o, int vb, bf16x8 pa0, bf16x8 pa1, bf16x8 pa2, bf16x8 pa3) {
  pv_one<0>(o[0], vb, pa0, pa1, pa2, pa3); pv_one<1>(o[1], vb, pa0, pa1, pa2, pa3); pv_one<2>(o[2], vb, pa0, pa1, pa2, pa3); pv_one<3>(o[3], vb, pa0, pa1, pa2, pa3);
}
__device__ __forceinline__ void attn_unit(const bf16* __restrict__ Qb, const bf16* __restrict__ Kh, const bf16* __restrict__ Vh, bf16* __restrict__ Ob, int seq,
                                          const float* __restrict__ qg, const float* __restrict__ rc, const float* __restrict__ rs, char* lds, int wave_) {
  const int tid = opaque_tid(wave_), wid = tid >> 6, lane = tid & 63, r32 = lane & 31, hi = lane >> 5;
  bf16* V_lds = (bf16*)lds; bf16* K_lds = (bf16*)(lds + 2 * SHM_V);
  float* ws = (float*)(lds + 2 * SHM_V + 2 * SHM_K) + wid * 64; float* li_l = ws; float* al_l = ws + 32;
  float m_reg = -1e30f, l_reg = 0; f32x16 o[4] = {}; bf16x8 qr[8];
  {
    const bf16* Qw = Qb + (long)(wid * QBLK + r32) * LDQ + hi * 8;
#pragma unroll
    for (int d0 = 0; d0 < 8; ++d0) qr[d0] = *reinterpret_cast<const bf16x8*>(Qw + d0 * 16);
  }
  const int sr = tid >> 4, sc = (tid & 15) * 8, vst0 = v_st(sr, sc), vst1 = v_st(32 + sr, sc);
  const int vb0 = (int)(uintptr_t)V_lds + v_rd_base(lane);
  struct { bf16x8 vs0, vs1, ks0, ks1; } sr_[2];
#define SLOAD(i, k0) do { sr_[i].vs0 = *reinterpret_cast<const bf16x8*>(&Vh[(long)((k0) + sr) * LDK + sc]); sr_[i].vs1 = *reinterpret_cast<const bf16x8*>(&Vh[(long)((k0) + 32 + sr) * LDK + sc]); \
    sr_[i].ks0 = *reinterpret_cast<const bf16x8*>(&Kh[(long)((k0) + sr) * LDK + sc]); sr_[i].ks1 = *reinterpret_cast<const bf16x8*>(&Kh[(long)((k0) + 32 + sr) * LDK + sc]); } while (0)
#define SWRITE(b, i) do { *(bf16x8*)((char*)V_lds + (b) * SHM_V + vst0) = sr_[i].vs0;          \
    *(bf16x8*)((char*)V_lds + (b) * SHM_V + vst1) = sr_[i].vs1; int kc = sc * 2;               \
    *(bf16x8*)((char*)K_lds + (b) * SHM_K + KSWZ(sr, kc)) = sr_[i].ks0;                       \
    *(bf16x8*)((char*)K_lds + (b) * SHM_K + KSWZ(32 + sr, kc)) = sr_[i].ks1; } while (0)
#define SWAIT() asm volatile("s_waitcnt vmcnt(4)" ::: "memory")
#define RESC(a) do { if (__any((a) < 1.f)) { if (hi == 0) al_l[r32] = (a); asm volatile("s_waitcnt lgkmcnt(0)" ::: "memory"); \
    for (int d = 0; d < 4; ++d) for (int r = 0; r < 16; ++r) o[d][r] *= al_l[crow(r, hi)]; } } while (0)
  f32x16 pA0, pA1, pB0, pB1; float mnA, mnB, alA, alB; bf16x8 pa0, pa1, pa2, pa3; const int NTL = seq / KVBLK;
  constexpr int SE = 0, SO = 1;
  SLOAD(SE, 0); asm volatile("s_waitcnt vmcnt(0)" ::: "memory"); SWRITE(0, SE); __syncthreads();
  qkt(pA0, pA1, K_lds, qr, r32, hi); partialSM(pA0, pA1, m_reg, mnA, alA);
  SLOAD(SO, KVBLK); if (2 < NTL) SLOAD(SE, 2 * KVBLK);
  SWAIT(); SWRITE(1, SO); __syncthreads();
  for (int j = 1; j + 1 < NTL; j += 2) {
    SBAR(); qkt(pB0, pB1, (bf16*)((char*)K_lds + SHM_K), qr, r32, hi);
    finishSM(pA0, pA1, alA, l_reg, pa0, pa1, pa2, pa3); SBAR();
    SLOAD(SO, (j + 2) * KVBLK); SBAR();
    pv_d0(o, vb0, pa0, pa1, pa2, pa3); partialSM(pB0, pB1, m_reg, mnB, alB);
    __syncthreads(); SWAIT(); SWRITE(0, SE);
    RESC(alB); __syncthreads();
    SBAR(); qkt(pA0, pA1, K_lds, qr, r32, hi);
    finishSM(pB0, pB1, alB, l_reg, pa0, pa1, pa2, pa3); SBAR();
    if (j + 3 < NTL) SLOAD(SE, (j + 3) * KVBLK); SBAR();
    pv_d0(o, vb0 + (int)SHM_V, pa0, pa1, pa2, pa3); partialSM(pA0, pA1, m_reg, mnA, alA);
    __syncthreads(); SWAIT(); SWRITE(1, SO);
    RESC(alA); __syncthreads();
  }
  SBAR(); qkt(pB0, pB1, (bf16*)((char*)K_lds + SHM_K), qr, r32, hi);
  finishSM(pA0, pA1, alA, l_reg, pa0, pa1, pa2, pa3); SBAR();
  pv_d0(o, vb0, pa0, pa1, pa2, pa3); partialSM(pB0, pB1, m_reg, mnB, alB);
  __syncthreads(); RESC(alB);
  finishSM(pB0, pB1, alB, l_reg, pa0, pa1, pa2, pa3); SBAR();
  pv_d0(o, vb0 + (int)SHM_V, pa0, pa1, pa2, pa3);
  if (hi == 0) li_l[r32] = l_reg; asm volatile("s_waitcnt lgkmcnt(0)" ::: "memory");
  float rli[16];
#pragma unroll
  for (int r = 0; r < 16; ++r) rli[r] = __builtin_amdgcn_rcpf(li_l[crow(r, hi)]);
  __syncthreads();
  {
    constexpr int SP = 272;
    LAS unsigned char* stg = (LAS unsigned char*)lds + wid * (32 * SP);
#pragma unroll
    for (int r = 0; r < 16; ++r) { LAS unsigned char* p = stg + crow(r, hi) * SP + r32 * 2;
#pragma unroll
      for (int d0 = 0; d0 < 4; d0 += 2) { const unsigned pk = cvt_pk_bf16(o[d0][r] * rli[r], o[d0 + 1][r] * rli[r]);
        *(LAS unsigned short*)(p + d0 * 64) = (unsigned short)pk; *(LAS unsigned short*)(p + (d0 + 1) * 64) = (unsigned short)(pk >> 16); } }
    asm volatile("s_waitcnt lgkmcnt(0)" ::: "memory");
    bf16* Ow = Ob + (long)(wid * QBLK) * LDO;
#pragma unroll
    for (int j = 0; j < 8; ++j) { const int row = 4 * j + (lane >> 4), ck = lane & 15;
      const u32x4 w = *(const LAS u32x4*)(stg + row * SP + ck * 16);
      *(u32x4*)(Ow + (long)row * LDO + ck * 8) = w; }
  }
#undef SLOAD
#undef SWRITE
#undef SWAIT
#undef RESC
}
}

struct Args { const float* in[38]; float* out; unsigned char* ws; };
enum { I_X = 0, I_C, I_CTX, I_CCTX, I_WMOD, I_BMOD, I_N1G, I_N2G, I_AWIN, I_AWOUT, I_QG, I_KG, I_MU, I_WR, I_WK, I_WV, I_WO, I_DW0, I_DW1, I_DW2, I_IA0, I_IA1, I_IA2,
       I_GG1, I_GG2, I_KK, I_KA, I_RK, I_LNG, I_LNB, I_V0, I_V1, I_V2, I_WUP, I_CW, I_CB, I_WDN, I_FNG };

struct Frame {
    LAS unsigned char* lds; char* ldsg;
    int vcu, G, NGW, wave;
    unsigned char* ws;
};
constexpr int EX_OFF = RING_BYTES + 2048;
constexpr int PTAB_OFF = RING_BYTES + 1024;
__device__ __forceinline__ const float* in_ptr(const Frame& F, int i) {
    const LAS unsigned* p = (const LAS unsigned*)(F.lds + opaque_s(PTAB_OFF + 8 * i));
    const unsigned lo = (unsigned)__builtin_amdgcn_readfirstlane((int)p[0]), hi = (unsigned)__builtin_amdgcn_readfirstlane((int)p[1]);
    return (const float*)(((unsigned long long)hi << 32) | lo);
}
#define PHASE_IDS() const int wave = opaque_s(F.wave), tid = opaque_tid(wave), lane = tid & 63, gw = F.vcu * 8 + wave, NGW = F.NGW; (void)lane; (void)gw; (void)NGW

__device__ __forceinline__ void transpose_item(const float* W, int ldw, int coloff, int N, bf16* WT, int ldt, int row_off, LAS float* scr, int item, int lane, bool perm_up = false) {
    const int nblk = N / 32, kb = item / nblk, nb = item % nblk, k0 = 64 * kb, n0 = 32 * nb;
    if (perm_up) row_off = ((n0 % DFF) / 128) * 256 + (n0 / DFF) * 128 + (n0 % 128) - n0;
    const int r8 = lane >> 3, c4 = (lane & 7) * 4;
    f32x4 v[8];
#pragma unroll
    for (int i = 0; i < 8; ++i) v[i] = __builtin_nontemporal_load((const f32x4*)(W + (size_t)(k0 + i * 8 + r8) * ldw + coloff + n0 + c4));
#pragma unroll
    for (int i = 0; i < 8; ++i) { LAS float* d = scr + (i * 8 + r8) * 33 + c4; d[0] = v[i][0]; d[1] = v[i][1]; d[2] = v[i][2]; d[3] = v[i][3]; }
    LDS_WAIT(); asm volatile("" ::: "memory");
    const int c = lane & 7;
#pragma unroll
    for (int j = 0; j < 4; ++j) { const int n = (lane >> 3) + 8 * j; const LAS float* s = scr + (8 * c) * 33 + n;
        u32x4 o; o.x = pk2(s[0 * 33], s[1 * 33]); o.y = pk2(s[2 * 33], s[3 * 33]); o.z = pk2(s[4 * 33], s[5 * 33]); o.w = pk2(s[6 * 33], s[7 * 33]);
        *(u32x4*)(WT + (size_t)(row_off + n0 + n) * ldt + k0 + 8 * c) = o; }
    LDS_WAIT(); asm volatile("" ::: "memory");
}
__device__ __forceinline__ void transpose_item32(const float* W, int ldw, int N, bf16* WT, int ldt, int row_off, int col_off, LAS float* scr, int item, int lane) {
    const int nblk = N / 32, kb = item / nblk, nb = item % nblk, k0 = 32 * kb, n0 = 32 * nb;
    const int r8 = lane >> 3, c4 = (lane & 7) * 4;
    f32x4 v[4];
#pragma unroll
    for (int i = 0; i < 4; ++i) v[i] = __builtin_nontemporal_load((const f32x4*)(W + (size_t)(k0 + i * 8 + r8) * ldw + n0 + c4));
#pragma unroll
    for (int i = 0; i < 4; ++i) { LAS float* d = scr + (i * 8 + r8) * 33 + c4; d[0] = v[i][0]; d[1] = v[i][1]; d[2] = v[i][2]; d[3] = v[i][3]; }
    LDS_WAIT(); asm volatile("" ::: "memory");
    const int c = lane & 3;
#pragma unroll
    for (int j = 0; j < 2; ++j) { const int n = (lane >> 2) + 16 * j; const LAS float* s = scr + (8 * c) * 33 + n;
        u32x4 o; o.x = pk2(s[0 * 33], s[1 * 33]); o.y = pk2(s[2 * 33], s[3 * 33]); o.z = pk2(s[4 * 33], s[5 * 33]); o.w = pk2(s[6 * 33], s[7 * 33]);
        *(u32x4*)(WT + (size_t)(row_off + n0 + n) * ldt + col_off + k0 + 8 * c) = o; }
    LDS_WAIT(); asm volatile("" ::: "memory");
}

__device__ __forceinline__ void p0_prologue(const Frame& F) {
    PHASE_IDS();
    LAS float* scr = (LAS float*)(F.lds + wave * 16384);
    unsigned char* ws = F.ws;
    {
        constexpr int P_UP = 32 * 352, P_DN = 88 * 64, P_QKV = 32 * 80, P_SQ = 32 * 64;
        constexpr int NITEMS = 4 * P_UP + 4 * P_DN + 2 * P_QKV + 2 * P_SQ + 8 * P_SQ;
        const bool defer = (F.G == 256);
        for (int it = gw; it < NITEMS; it += NGW) {
            int r = it;
            if (r < 4 * P_UP) { const int l = r / P_UP; if (defer) continue; transpose_item(in_ptr(F, I_WUP) + (size_t)l * DM * DFF2, DFF2, 0, DFF2, (bf16*)(ws + WS_WUP) + (size_t)l * DFF2 * DM, DM, 0, scr, r % P_UP, lane, true); continue; } r -= 4 * P_UP;
            if (r < 4 * P_DN) { const int l = r / P_DN; if (defer) continue; transpose_item(in_ptr(F, I_WDN) + (size_t)l * DFF * DM, DM, 0, DM, (bf16*)(ws + WS_WDN) + (size_t)l * DM * DFF, DFF, 0, scr, r % P_DN, lane); continue; } r -= 4 * P_DN;
            if (r < 2 * P_QKV) { const int l = r / P_QKV; transpose_item(in_ptr(F, I_AWIN) + (size_t)l * DM * WIN, WIN, 0, NQKV, (bf16*)(ws + WS_WQKV) + (size_t)l * NQKV * DM, DM, 0, scr, r % P_QKV, lane); continue; } r -= 2 * P_QKV;
            if (r < 2 * P_SQ) { const int l = r / P_SQ; transpose_item(in_ptr(F, I_AWOUT) + (size_t)l * DM * DM, DM, 0, DM, (bf16*)(ws + WS_WOUT) + (size_t)l * DM * DM, DM, 0, scr, r % P_SQ, lane); continue; } r -= 2 * P_SQ;
            { const int mi = r / P_SQ, l = mi >> 2, which = mi & 3; if (defer) continue;
              const float* src = (which == 0 ? in_ptr(F, I_WR) : (which == 1 ? in_ptr(F, I_WK) : (which == 2 ? in_ptr(F, I_WV) : in_ptr(F, I_WO)))) + (size_t)l * DM * DM;
              transpose_item(src, DM, 0, DM, (bf16*)(ws + WS_WRKVO) + (size_t)mi * DM * DM, DM, 0, scr, r % P_SQ, lane); }
        }
    }
    {
        float* PART = (float*)(ws + WS_H);
        const float* cvec = in_ptr(F, I_C); const float* cctx = in_ptr(F, I_CCTX); const float* wmod = in_ptr(F, I_WMOD);
        for (int it = gw; it < 4 * 8 * 48; it += NGW) {
            const int i = it / 384, r = it % 384, kc = r / 48, nb = r % 48;
#pragma unroll
            for (int q = 0; q < 4; ++q) { const int kk = lane + 64 * q, k = kc * 256 + kk;
#pragma unroll
                for (int rc = 0; rc < 5; ++rc) { const float cv = (rc < 4) ? cvec[rc * DM + k] : cctx[k]; scr[rc * 256 + kk] = cv / (1.0f + __expf(-cv)); } }
            LDS_WAIT(); asm volatile("" ::: "memory");
            f32x4 acc[5];
#pragma unroll
            for (int rc = 0; rc < 5; ++rc) acc[rc] = (f32x4){0.f, 0.f, 0.f, 0.f};
            const float* wp = wmod + ((size_t)i * DM + (size_t)kc * 256) * 12288 + nb * 256 + lane * 4;
#pragma unroll 8
            for (int kk = 0; kk < 256; ++kk) { const f32x4 w4 = __builtin_nontemporal_load((const f32x4*)(wp + (size_t)kk * 12288));
#pragma unroll
                for (int rc = 0; rc < 5; ++rc) acc[rc] += scr[rc * 256 + kk] * w4; }
#pragma unroll
            for (int rc = 0; rc < 5; ++rc) *(f32x4*)(PART + ((size_t)(kc * 4 + i) * 5 + rc) * 12288 + nb * 256 + lane * 4) = acc[rc];
            LDS_WAIT(); asm volatile("" ::: "memory");
        }
    }
    const long gt = (long)F.vcu * 512 + tid, NGT = (long)F.G * 512;
    {
        float* RC = (float*)(ws + WS_ROPEC); float* RS = (float*)(ws + WS_ROPES);
        for (long idx = gt; idx < 4096 * 64; idx += NGT) { const int t = (int)(idx >> 6), i = (int)(idx & 63);
            const int pos = (i < 32) ? (t >> 6) : (t & 63); const float inv = powf(10000.0f, -(float)(2 * (i & 31)) / 64.0f);
            const float ang = (float)pos * inv; RC[idx] = cosf(ang); RS[idx] = sinf(ang); }
    }
    {
        bf16* AD = (bf16*)(ws + WS_ADFT);
        const float sL = 0.0013810679320049757f, sC = 0.005524271728019903f;
        for (long idx = gt; idx < (long)4096 * 1024; idx += NGT) { const int k1 = (int)(idx >> 10), cg = (int)(idx & 1023), n0 = (cg & 511) * 8; const bool isS = cg >= 512;
            float s0, c0, sd, cd; sincospif((float)((k1 * n0) & 4095) * (1.0f / 2048.0f), &s0, &c0); sincospif((float)k1 * (1.0f / 2048.0f), &sd, &cd);
            float v[8];
#pragma unroll
            for (int e = 0; e < 8; ++e) { v[e] = isS ? -s0 * sL : c0 * sL; const float c1 = c0 * cd - s0 * sd, s1 = s0 * cd + c0 * sd; c0 = c1; s0 = s1; }
            u32x4 w; w.x = pk2(v[0], v[1]); w.y = pk2(v[2], v[3]); w.z = pk2(v[4], v[5]); w.w = pk2(v[6], v[7]);
            *(u32x4*)(AD + (size_t)k1 * 8192 + cg * 8) = w; }
        for (long idx = gt; idx < (long)256 * 64; idx += NGT) { const int k1 = (int)(idx >> 6), cg = (int)(idx & 63), n0 = (cg & 31) * 8; const bool isS = cg >= 32;
            float v[8];
#pragma unroll
            for (int e = 0; e < 8; ++e) { const int mm = (k1 * (n0 + e)) & 255; float s, c; sincospif((float)mm * (1.0f / 128.0f), &s, &c); v[e] = isS ? -s * sC : c * sC; }
            u32x4 w; w.x = pk2(v[0], v[1]); w.y = pk2(v[2], v[3]); w.z = pk2(v[4], v[5]); w.w = pk2(v[6], v[7]);
            *(u32x4*)(AD + (size_t)(4096 + k1) * 8192 + cg * 8) = w; }
    }
    {
        LAS float* tab = scr + 1024;
        for (int q = 0; q < 4; ++q) { const int m = lane + 64 * q; float sn, cs; sincospif((float)(m & 127) * (1.0f / 64.0f), &sn, &cs); tab[m] = (m < 128) ? cs : sn; }
        for (int it = gw; it < 2048; it += NGW) {
            const int ko = it & 255, g = (it >> 8) & 3, lp = it >> 10;
            const float* wf = in_ptr(F, I_AWIN) + (size_t)lp * DM * WIN + (size_t)(ko * 8) * WIN + NQKV + g * 128;
#pragma unroll
            for (int q = 0; q < 4; ++q) { const int e = lane + 64 * q, kk = e >> 5, c4 = (e & 31) * 4; const f32x4 x = *(const f32x4*)(wf + (size_t)kk * WIN + c4);
                scr[(c4 + 0) * 8 + kk] = x[0]; scr[(c4 + 1) * 8 + kk] = x[1]; scr[(c4 + 2) * 8 + kk] = x[2]; scr[(c4 + 3) * 8 + kk] = x[3]; }
            LDS_WAIT(); asm volatile("" ::: "memory");
            float acc[4][8];
#pragma unroll
            for (int o = 0; o < 4; ++o)
#pragma unroll
                for (int kk = 0; kk < 8; ++kk) acc[o][kk] = 0.f;
            for (int c = 0; c < 128; ++c) {
                const f32x4 f0 = *(const LAS f32x4*)(scr + c * 8), f1 = *(const LAS f32x4*)(scr + c * 8 + 4);
                const int m0 = (lane * c) & 127, m1 = ((lane + 64) * c) & 127;
                const float t[4] = {tab[m0], tab[m1], tab[128 + m0], tab[128 + m1]};
#pragma unroll
                for (int o = 0; o < 4; ++o) {
#pragma unroll
                    for (int kk = 0; kk < 4; ++kk) { acc[o][kk] += f0[kk] * t[o]; acc[o][4 + kk] += f1[kk] * t[o]; } }
            }
#pragma unroll
            for (int o = 0; o < 4; ++o) { const int pq = o >> 1, k2 = (o & 1) * 64 + lane;
                u32x4 w; w.x = pk2(acc[o][0], acc[o][1]); w.y = pk2(acc[o][2], acc[o][3]); w.z = pk2(acc[o][4], acc[o][5]); w.w = pk2(acc[o][6], acc[o][7]);
                *(u32x4*)((bf16*)(ws + WS_WPQ) + (size_t)lp * 1024 * DM + (size_t)(pq * 512 + g * 128 + k2) * DM + ko * 8) = w; }
            LDS_WAIT(); asm volatile("" ::: "memory");
        }
    }
    {
        bf16* L1b = (bf16*)(ws + WS_L1);
        for (int it = gw; it < 2 * 704; it += NGW) {
            const int j = it / 704; int r = it % 704; bf16* dst = L1b + (size_t)j * 1024 * DM;
            if (r < 192) { const int d = r / 96; transpose_item(in_ptr(F, I_DW1) + (size_t)(j * 2 + d) * DM * 96, 96, 0, 96, dst, DM, d * 128, scr, r % 96, lane); continue; } r -= 192;
            if (r < 192) { const int d = r / 96; transpose_item(in_ptr(F, I_IA1) + (size_t)(j * 2 + d) * DM * 96, 96, 0, 96, dst, DM, 256 + d * 128, scr, r % 96, lane); continue; } r -= 192;
            if (r < 256) { transpose_item(in_ptr(F, I_GG1) + (size_t)j * DM * 256, 256, 0, 256, dst, DM, 512, scr, r, lane); continue; } r -= 256;
            if (j == 1) transpose_item(in_ptr(F, I_V1), 64, 0, 64, dst, DM, 768, scr, r, lane);
        }
        for (int it = gw; it < 2 * 1408; it += NGW) {
            const int j = it / 1408; int r = it % 1408; unsigned char* base = ws + WS_L2 + (size_t)j * 6 * MiB;
            if (r < 384) { const int d = r / 192; transpose_item32(in_ptr(F, I_DW2) + (size_t)(j * 2 + d) * 96 * DM, DM, DM, (bf16*)base, 256, d * DM, d * 128, scr, r % 192, lane); continue; } r -= 384;
            if (r < 384) { const int d = r / 192; transpose_item32(in_ptr(F, I_IA2) + (size_t)(j * 2 + d) * 96 * DM, DM, DM, (bf16*)(base + 2 * MiB), 256, d * DM, d * 128, scr, r % 192, lane); continue; } r -= 384;
            if (r < 512) { transpose_item32(in_ptr(F, I_GG2) + (size_t)j * 256 * DM, DM, DM, (bf16*)(base + 4 * MiB), 256, 0, 0, scr, r, lane); continue; } r -= 512;
            if (j == 1) transpose_item32(in_ptr(F, I_V2), DM, DM, (bf16*)(base + 5 * MiB), 256, 0, 0, scr, r, lane);
        }
        const u32x4 z = {0u, 0u, 0u, 0u};
        for (long idx = gt; idx < (long)2 * 384 * 256; idx += NGT) {
            const int j = (int)(idx / (384 * 256)), r = (int)((idx / 256) % 384), cg = (int)(idx & 255);
            const int row = (r < 128) ? (r >> 5) * 128 + 96 + (r & 31) : 768 + (r - 128);
            if (j == 1 && row >= 768 && row < 832) continue;
            *(u32x4*)(L1b + ((size_t)j * 1024 + row) * DM + cg * 8) = z; }
        for (long idx = gt; idx < (long)2 * 2 * 4096 * 20; idx += NGT) {
            const int ck = (int)(idx % 20), n = (int)((idx / 20) & 4095), sel = (int)((idx / (20 * 4096)) & 1), j = (int)(idx / (2 * 20 * 4096)), d = n >> 11;
            const int chunk = (d == 0) ? 12 + ck : (ck < 16 ? ck : 12 + ck);
            *(u32x4*)((bf16*)(ws + WS_L2 + (size_t)j * 6 * MiB + (size_t)sel * 2 * MiB) + (size_t)n * 256 + chunk * 8) = z; }
        for (long idx = gt; idx < (long)2048 * 24; idx += NGT) {
            const int ck = (int)(idx % 24), n = (int)(idx / 24);
            *(u32x4*)((bf16*)(ws + WS_L2 + (size_t)6 * MiB + 5 * MiB) + (size_t)n * 256 + 64 + ck * 8) = z; }
    }
}

__device__ __forceinline__ void mod_finalize(const Frame& F) {
    PHASE_IDS();
    float* MOD = (float*)(F.ws + WS_CTL) + CW_MOD; const float* PART = (const float*)(F.ws + WS_H); const float* bmod = in_ptr(F, I_BMOD);
    const long gt = (long)F.vcu * 512 + tid, NGT = (long)F.G * 512;
    for (long idx = gt; idx < 4 * 5 * 12288; idx += NGT) { const int n = (int)(idx % 12288), i = (int)(idx / (5 * 12288));
        float sacc = bmod[(size_t)i * 12288 + n];
#pragma unroll
        for (int kc = 0; kc < 8; ++kc) sacc += PART[(size_t)kc * 4 * 5 * 12288 + idx];
        MOD[idx] = sacc; }
}
__device__ __forceinline__ void norm_phase(const Frame& F, int layer, int which, bool first, int fold, bool lat_only) {
    const float* MOD = (const float*)(F.ws + WS_CTL) + CW_MOD;
    bf16* X = (bf16*)(F.ws + WS_X); bf16* H = (bf16*)(F.ws + WS_H); const unsigned short* PART = (const unsigned short*)(F.ws + WS_PART);
    const float* g = (which == 0 ? in_ptr(F, I_N1G) : in_ptr(F, I_N2G)) + (size_t)layer * DM;
    const float* xin = in_ptr(F, I_X); const float* cin = in_ptr(F, I_CTX);
    PHASE_IDS();
#define NP_COL(j_) ((64 * ((j_) >> 1) + lane) * 8 + ((j_) & 1) * 4)
#define NP_SRC(row_) ({ const int b_ = (row_) / TPB, n_ = (row_) % TPB; const float* s_ = (n_ < CTXL) ? cin + ((size_t)b_ * CTXL + n_) * DM : xin + ((size_t)b_ * SEQ + (n_ - CTXL)) * DM; (const f32x4*)s_ + 2 * lane; })
#define NP_LOAD(row_) do { if (first) { const f32x4* xr = NP_SRC(row_); _Pragma("unroll") for (int p = 0; p < 4; ++p) { vn[2 * p] = __builtin_nontemporal_load(xr + 128 * p); vn[2 * p + 1] = __builtin_nontemporal_load(xr + 128 * p + 1); } } \
                           else { const u32x4* xb = (const u32x4*)(X + (size_t)(row_) * DM) + lane; _Pragma("unroll") for (int p = 0; p < 4; ++p) vb[p] = xb[64 * p]; } } while (0)
    f32x4 vn[8]; u32x4 vb[4];
    f32x4 g4[8], gs4[8], sh4[8]; int rc_cur = -1;
#pragma unroll
    for (int j = 0; j < 8; ++j) { g4[j] = *(const f32x4*)(g + NP_COL(j)); gs4[j] = g4[j]; sh4[j] = g4[j]; vn[j] = (f32x4){0.f, 0.f, 0.f, 0.f}; }
#pragma unroll
    for (int p = 0; p < 4; ++p) vb[p] = (u32x4){0u, 0u, 0u, 0u};
    int row = gw;
    if (row < NT) NP_LOAD(row);
    for (; row < NT; row += NGW) {
        const int b = row / TPB, n = row % TPB; const bool isctx = n < CTXL; const int rc = isctx ? 4 : b;
        f32x4 v[8];
#pragma unroll
        for (int p = 0; p < 4; ++p) { v[2 * p] = first ? vn[2 * p] : (f32x4){hlo(vb[p].x), hhi(vb[p].x), hlo(vb[p].y), hhi(vb[p].y)};
                                      v[2 * p + 1] = first ? vn[2 * p + 1] : (f32x4){hlo(vb[p].z), hhi(vb[p].z), hlo(vb[p].w), hhi(vb[p].w)}; }
        if (row + NGW < NT) NP_LOAD(row + NGW);
        if (isctx && lat_only) continue;
        float s = 0.f;
        u32x4* xo = (u32x4*)(X + (size_t)row * DM) + lane;
        if (isctx && fold >= 0) {
            const float* gp = MOD + fold + 4 * 12288; const unsigned short* pp = PART + ((size_t)b * 256 + n) * DM;
#pragma unroll
            for (int p = 0; p < 4; ++p) { f32x4 ps0 = (f32x4){0.f, 0.f, 0.f, 0.f}, ps1 = ps0;
#pragma unroll
                for (int sl = 0; sl < 8; ++sl) { const u32x4 t = *(const u32x4*)(pp + (size_t)sl * 1024 * DM + (64 * p + lane) * 8);
                    ps0 += (f32x4){hlo(t.x), hhi(t.x), hlo(t.y), hhi(t.y)}; ps1 += (f32x4){hlo(t.z), hhi(t.z), hlo(t.w), hhi(t.w)}; }
                v[2 * p] += *(const f32x4*)(gp + NP_COL(2 * p)) * ps0; v[2 * p + 1] += *(const f32x4*)(gp + NP_COL(2 * p + 1)) * ps1;
                u32x4 w; w.x = pk2h(v[2 * p].x, v[2 * p].y); w.y = pk2h(v[2 * p].z, v[2 * p].w); w.z = pk2h(v[2 * p + 1].x, v[2 * p + 1].y); w.w = pk2h(v[2 * p + 1].z, v[2 * p + 1].w); xo[64 * p] = w; }
        }
#pragma unroll
        for (int j = 0; j < 8; ++j) s += (v[j].x * v[j].x + v[j].y * v[j].y) + (v[j].z * v[j].z + v[j].w * v[j].w);
        const float rstd = rsqrtf(wave_sum(s) * (1.0f / DM) + 1e-6f);
        if (first) {
#pragma unroll
            for (int p = 0; p < 4; ++p) { u32x4 w; w.x = pk2h(v[2 * p].x, v[2 * p].y); w.y = pk2h(v[2 * p].z, v[2 * p].w); w.z = pk2h(v[2 * p + 1].x, v[2 * p + 1].y); w.w = pk2h(v[2 * p + 1].z, v[2 * p + 1].w); xo[64 * p] = w; } }
        if (rc != rc_cur) { rc_cur = rc;
            const float* sh = MOD + (size_t)(layer * 5 + rc) * 12288 + (size_t)(which * 3) * DM; const float* sc = sh + DM;
#pragma unroll
            for (int j = 0; j < 8; ++j) { const int col = NP_COL(j); sh4[j] = *(const f32x4*)(sh + col); gs4[j] = g4[j] * (*(const f32x4*)(sc + col) + 1.0f); } }
        u32x4* o8 = (u32x4*)(H + (size_t)row * DM) + lane;
#pragma unroll
        for (int p = 0; p < 4; ++p) { const f32x4 y0 = (v[2 * p] * rstd) * gs4[2 * p] + sh4[2 * p], y1 = (v[2 * p + 1] * rstd) * gs4[2 * p + 1] + sh4[2 * p + 1];
            u32x4 w; w.x = pk2(y0.x, y0.y); w.y = pk2(y0.z, y0.w); w.z = pk2(y1.x, y1.y); w.w = pk2(y1.z, y1.w); o8[64 * p] = w; }
    }
#undef NP_LOAD
#undef NP_SRC
#undef NP_COL
}
__device__ __forceinline__ void final_norm_phase(const Frame& F) {
    const bf16* X = (const bf16*)(F.ws + WS_X); const float* g = in_ptr(F, I_FNG);
    PHASE_IDS();
    f32x4 g4[8];
#pragma unroll
    for (int j = 0; j < 8; ++j) g4[j] = *(const f32x4*)(g + (64 * (j >> 1) + lane) * 8 + (j & 1) * 4);
    for (int r = gw; r < NBATCH * SEQ; r += NGW) {
        const int b = r / SEQ, t = r % SEQ; const size_t row = (size_t)b * TPB + CTXL + t;
        const u32x4* xr = (const u32x4*)(X + row * DM) + lane;
        f32x4 v[8]; float s = 0.f;
#pragma unroll
        for (int p = 0; p < 4; ++p) { const u32x4 t4 = xr[64 * p]; v[2 * p] = (f32x4){hlo(t4.x), hhi(t4.x), hlo(t4.y), hhi(t4.y)}; v[2 * p + 1] = (f32x4){hlo(t4.z), hhi(t4.z), hlo(t4.w), hhi(t4.w)}; }
#pragma unroll
        for (int j = 0; j < 8; ++j) s += (v[j].x * v[j].x + v[j].y * v[j].y) + (v[j].z * v[j].z + v[j].w * v[j].w);
        const float rstd = rsqrtf(wave_sum(s) * (1.0f / DM) + 1e-6f);
        f32x4* o = (f32x4*)((float*)in_ptr(F, 38) + (size_t)r * DM) + 2 * lane;
#pragma unroll
        for (int p = 0; p < 4; ++p) { __builtin_nontemporal_store((v[2 * p] * rstd) * g4[2 * p], o + 128 * p); __builtin_nontemporal_store((v[2 * p + 1] * rstd) * g4[2 * p + 1], o + 128 * p + 1); }
    }
}
__device__ __forceinline__ void deferred_transposes(const Frame& F, const int slot) {
    PHASE_IDS();
    LAS float* scr = (LAS float*)(F.lds + wave * 16384);
    constexpr int P_UP = 32 * 352, P_DN = 88 * 64, P_SQ = 32 * 64;
    const int l = 3 * slot, n_all = P_UP + P_DN + 4 * P_SQ;
    for (int it = F.vcu * 8 + wave; it < n_all; it += 128 * 8) {
        int r = it;
        if (r < P_UP) { transpose_item(in_ptr(F, I_WUP) + (size_t)l * DM * DFF2, DFF2, 0, DFF2, (bf16*)(F.ws + WS_WUP) + (size_t)l * DFF2 * DM, DM, 0, scr, r, lane, true); continue; } r -= P_UP;
        if (r < P_DN) { transpose_item(in_ptr(F, I_WDN) + (size_t)l * DFF * DM, DM, 0, DM, (bf16*)(F.ws + WS_WDN) + (size_t)l * DM * DFF, DFF, 0, scr, r, lane); continue; } r -= P_DN;
        { const int which = r / P_SQ, mi = slot * 4 + which;
          const float* src = (which == 0 ? in_ptr(F, I_WR) : (which == 1 ? in_ptr(F, I_WK) : (which == 2 ? in_ptr(F, I_WV) : in_ptr(F, I_WO)))) + (size_t)slot * DM * DM;
          transpose_item(src, DM, 0, DM, (bf16*)(F.ws + WS_WRKVO) + (size_t)mi * DM * DM, DM, 0, scr, r % P_SQ, lane); }
    }
}
__device__ __forceinline__ void tail_transposes(const Frame& F, const int l, const int i0, const int i1, const int rank, const int nranks) {
    PHASE_IDS();
    LAS float* scr = (LAS float*)(F.lds + wave * 16384);
    constexpr int P_UP = 32 * 352;
    for (int it = i0 + rank * 8 + wave; it < i1; it += nranks * 8) {
        if (it < P_UP) transpose_item(in_ptr(F, I_WUP) + (size_t)l * DM * DFF2, DFF2, 0, DFF2, (bf16*)(F.ws + WS_WUP) + (size_t)l * DFF2 * DM, DM, 0, scr, it, lane, true);
        else transpose_item(in_ptr(F, I_WDN) + (size_t)l * DFF * DM, DM, 0, DM, (bf16*)(F.ws + WS_WDN) + (size_t)l * DM * DFF, DFF, 0, scr, it - P_UP, lane);
    }
}
__device__ __forceinline__ void attn_phase(const Frame& F, int lp) {
    const bf16* QKV = (const bf16*)(F.ws + WS_QKV); bf16* MIX = (bf16*)(F.ws + WS_MIX);
    const float* RC = (const float*)(F.ws + WS_ROPEC); const float* RS = (const float*)(F.ws + WS_ROPES); const float* qg = in_ptr(F, I_QG) + (size_t)lp * 128;
    for (int i = 0;; ++i) {
        int uidx;
        if (F.G == 256) { const int v = F.vcu;
            if (v < 128) { if (i < 2) uidx = 2 * v + i; else if (i == 2 && v >= 8 && v < 56) uidx = 768 + (v - 8); else break; }
            else { if (i < 4) uidx = 256 + 4 * (v - 128) + i; else break; } }
        else { uidx = i * F.G + F.vcu; if (uidx >= 816) break; }
        if (uidx < 768) { const int b = uidx / 192, rem = uidx % 192, kvh = rem / 48, r2 = rem % 48, g = r2 >> 4, qb = r2 & 15, hq = kvh * 3 + g;
            const size_t qrow = (size_t)b * TPB + CTXL + qb * 256, krow = (size_t)b * TPB;
            att::attn_unit(QKV + qrow * NQKV + hq * 128, QKV + krow * NQKV + 1536 + kvh * 128, QKV + krow * NQKV + 2048 + kvh * 128, MIX + qrow * DM + hq * 128, TPB,
                           qg, RC + (size_t)qb * 256 * 64, RS + (size_t)qb * 256 * 64, F.ldsg, F.wave);
        } else { const int c = uidx - 768, b = c / 12, hq = c % 12, kvh = hq / 3; const size_t qrow = (size_t)b * TPB;
            att::attn_unit(QKV + qrow * NQKV + hq * 128, QKV + qrow * NQKV + 1536 + kvh * 128, QKV + qrow * NQKV + 2048 + kvh * 128, MIX + qrow * DM + hq * 128, CTXL,
                           qg, nullptr, nullptr, F.ldsg, F.wave);
        }
        __syncthreads();
    }
}
__device__ __forceinline__ void ffn_fixup_phase(const Frame& F, int layer) {
    const bf16* HALO = (const bf16*)(F.ws + WS_HALO); bf16* ACT = (bf16*)(F.ws + WS_ACT);
    const float* cw = in_ptr(F, I_CW) + (size_t)layer * 3 * DFF2; const float* cb = in_ptr(F, I_CB) + (size_t)layer * DFF2;
    PHASE_IDS();
    const long gt = (long)F.vcu * 512 + tid, NGT = (long)F.G * 512;
    for (long idx = gt; idx < (long)NPAN * 2 * 704; idx += NGT) {
        const int c8 = (int)(idx % 704), pe = (int)(idx / 704), pm = pe >> 1, edge = pe & 1, tix = pm % PPB;
        if (tix == 0 || (edge == 0 && tix == 1) || (edge == 1 && tix == PPB - 1)) continue;
        const int ch = c8 * 8, tcol = (ch >> 7) * 256 + (ch & 127);
        const bf16* r0 = HALO + ((size_t)(edge == 0 ? (pm - 1) * 4 + 3 : pm * 4 + 2)) * DFF2 + tcol;
        const bf16* r1 = HALO + ((size_t)(edge == 0 ? pm * 4 + 0 : pm * 4 + 3)) * DFF2 + tcol;
        const bf16* r2 = HALO + ((size_t)(edge == 0 ? pm * 4 + 1 : (pm + 1) * 4 + 0)) * DFF2 + tcol;
        const bf16* rr[3] = {r0, r1, r2};
        float pg[8], pv[8];
#pragma unroll
        for (int e = 0; e < 8; ++e) { pg[e] = cb[ch + e]; pv[e] = cb[DFF + ch + e]; }
#pragma unroll
        for (int t = 0; t < 3; ++t) { const u32x4 ug = *(const u32x4*)rr[t], uv = *(const u32x4*)(rr[t] + 128);
#pragma unroll
            for (int q = 0; q < 4; ++q) { pg[2 * q] += cw[(size_t)t * DFF2 + ch + 2 * q] * bflo(ug[q]); pg[2 * q + 1] += cw[(size_t)t * DFF2 + ch + 2 * q + 1] * bfhi(ug[q]);
                                          pv[2 * q] += cw[(size_t)t * DFF2 + DFF + ch + 2 * q] * bflo(uv[q]); pv[2 * q + 1] += cw[(size_t)t * DFF2 + DFF + ch + 2 * q + 1] * bfhi(uv[q]); } }
        float o[8];
#pragma unroll
        for (int e = 0; e < 8; ++e) o[e] = pg[e] * sigmoidf_(pg[e]) * pv[e];
        u32x4 w; w.x = pk2(o[0], o[1]); w.y = pk2(o[2], o[3]); w.z = pk2(o[4], o[5]); w.w = pk2(o[6], o[7]);
        *(u32x4*)(ACT + (size_t)(pm * 256 + (edge == 0 ? 0 : 255)) * DFF + ch) = w;
    }
}
__device__ __forceinline__ void mixes_phase(const Frame& F, int j) {
    const bf16* H = (const bf16*)(F.ws + WS_H); const float* mu = in_ptr(F, I_MU) + (size_t)j * 6 * DM;
    PHASE_IDS();
    const long gt = (long)F.vcu * 512 + tid, NGT = (long)F.G * 512;
    f32x4 mu0[6], mu1[6];
    { const int cgf = (int)(gt & 255);
#pragma unroll
      for (int m = 0; m < 6; ++m) { mu0[m] = *(const f32x4*)(mu + (size_t)m * DM + cgf * 8); mu1[m] = *(const f32x4*)(mu + (size_t)m * DM + cgf * 8 + 4); } }
    for (long idx0 = gt; idx0 < (long)NT * 256; idx0 += 2 * NGT) {
        u32x4 hc[2], hm[2], hn[2]; bool ok[2];
#pragma unroll
        for (int u = 0; u < 2; ++u) { const long idx = idx0 + u * NGT; ok[u] = idx < (long)NT * 256; hc[u] = hm[u] = hn[u] = (u32x4){0u, 0u, 0u, 0u};
            if (ok[u]) { const int row = (int)(idx >> 8), cg = (int)(idx & 255), n = row % TPB; const bf16* hp = H + (size_t)row * DM + cg * 8;
                hc[u] = *(const u32x4*)hp; if (!(n == 0 || n == CTXL)) hm[u] = *(const u32x4*)(hp - DM); if (!(n == CTXL - 1 || n == TPB - 1)) hn[u] = *(const u32x4*)(hp + DM); } }
#pragma unroll
        for (int u = 0; u < 2; ++u) { if (!ok[u]) continue;
            const long idx = idx0 + u * NGT; const int row = (int)(idx >> 8), cg = (int)(idx & 255);
            float h[8], dx[8];
#pragma unroll
            for (int q = 0; q < 4; ++q) { h[2 * q] = bflo(hc[u][q]); h[2 * q + 1] = bfhi(hc[u][q]);
                dx[2 * q] = 0.5f * (bflo(hm[u][q]) + bflo(hn[u][q])) - h[2 * q]; dx[2 * q + 1] = 0.5f * (bfhi(hm[u][q]) + bfhi(hn[u][q])) - h[2 * q + 1]; }
#pragma unroll
            for (int m = 0; m < 6; ++m) { const f32x4 m0 = mu0[m], m1 = mu1[m];
                float x[8];
#pragma unroll
                for (int e = 0; e < 4; ++e) { x[e] = h[e] + dx[e] * m0[e]; x[4 + e] = h[4 + e] + dx[4 + e] * m1[e]; }
                u32x4 w; w.x = pk2(x[0], x[1]); w.y = pk2(x[2], x[3]); w.z = pk2(x[4], x[5]); w.w = pk2(x[6], x[7]);
                *(u32x4*)((bf16*)(F.ws + WS_MIXES + (size_t)m * MIXSZ) + (size_t)row * DM + cg * 8) = w; }
        }
    }
}
typedef float f32x2 __attribute__((ext_vector_type(2)));
__device__ __forceinline__ float red8(float x) { x += dpp_mov<0x141>(x); x += dpp_mov<0xB1>(x); x += dpp_mov<0x4E>(x); return x; }
__device__ __forceinline__ void scan_prep_phase(const Frame& F, int j, const bf16* Vsrc) {
    const bf16* R = (const bf16*)(F.ws + WS_R); const bf16* K = (const bf16*)(F.ws + WS_K); const unsigned short* AA = (const unsigned short*)(F.ws + WS_AA);
    float* ST = (float*)(F.ws + WS_STATS);
    const float* pkk = in_ptr(F, I_KK) + (size_t)j * DM; const float* pka = in_ptr(F, I_KA) + (size_t)j * DM; const float* prk = in_ptr(F, I_RK) + (size_t)j * DM;
    PHASE_IDS();
    f32x4 wkk[4][2], wka[4][2], wrk[4][2];
#pragma unroll
    for (int q = 0; q < 4; ++q) { const int c0 = q * 512 + lane * 8;
        wkk[q][0] = *(const f32x4*)(pkk + c0); wkk[q][1] = *(const f32x4*)(pkk + c0 + 4); wka[q][0] = *(const f32x4*)(pka + c0); wka[q][1] = *(const f32x4*)(pka + c0 + 4);
        wrk[q][0] = *(const f32x4*)(prk + c0); wrk[q][1] = *(const f32x4*)(prk + c0 + 4); }
    for (int row = gw; row < NT; row += NGW) {
        u32x4 rr[4], kk4[4], a0[4], a1[4];
#pragma unroll
        for (int q = 0; q < 4; ++q) { const size_t o = (size_t)row * DM + q * 512 + lane * 8; rr[q] = *(const u32x4*)(R + o); kk4[q] = *(const u32x4*)(K + o);
            a0[q] = *(const u32x4*)(AA + (size_t)row * 4096 + q * 512 + lane * 8); a1[q] = *(const u32x4*)(AA + (size_t)row * 4096 + DM + q * 512 + lane * 8); }
#pragma unroll
        for (int q = 0; q < 4; ++q) {
            float r[8], k[8], kkw[8], kaw[8], rkw[8];
#pragma unroll
            for (int e = 0; e < 4; ++e) { r[2 * e] = bflo(rr[q][e]); r[2 * e + 1] = bfhi(rr[q][e]); k[2 * e] = bflo(kk4[q][e]); k[2 * e + 1] = bfhi(kk4[q][e]); }
            { const f32x4 x0 = wkk[q][0], x1 = wkk[q][1], y0 = wka[q][0], y1 = wka[q][1], z0 = wrk[q][0], z1 = wrk[q][1];
#pragma unroll
              for (int e = 0; e < 4; ++e) { kkw[e] = x0[e]; kkw[4 + e] = x1[e]; kaw[e] = y0[e]; kaw[4 + e] = y1[e]; rkw[e] = z0[e]; rkw[4 + e] = z1[e]; } }
            float n2 = 0.f;
#pragma unroll
            for (int e = 0; e < 8; ++e) { const float t = k[e] * kkw[e]; n2 += t * t; }
            const float ninv = 1.0f / fmaxf(sqrtf(red8(n2)), 1e-12f);
            float st[6];
#pragma unroll
            for (int d = 0; d < 2; ++d) { float br = 0.f, kr = 0.f, bon = 0.f;
#pragma unroll
                for (int e = 0; e < 8; ++e) { const unsigned aw = (d == 0) ? a0[q][e >> 1] : a1[q][e >> 1]; const float a = h2f((unsigned short)((e & 1) ? (aw >> 16) : (aw & 0xffffu)));
                    const float kd = k[e] * (1.0f + (a - 1.0f) * kaw[e]);
                    bon += r[e] * kd * rkw[e]; }
                st[3 * d] = 0.f; st[3 * d + 1] = 0.f; st[3 * d + 2] = red8(bon); (void)br; (void)kr; }
            if ((lane & 7) == 0) { float* o = ST + ((size_t)row * 32 + q * 8 + (lane >> 3)) * 8; *(f32x4*)o = (f32x4){ninv, st[0], st[1], st[2]}; *(f32x4*)(o + 4) = (f32x4){st[3], st[4], st[5], 0.f}; }
        }
    }
    (void)Vsrc;
}
typedef short bf16x4 __attribute__((ext_vector_type(4)));
constexpr int CS_KS = 72, CS_TS = 36;
constexpr int CS_AL = 0, CS_RH = 16 * CS_KS * 2, CS_BE = 2 * CS_RH, CS_KA = 3 * CS_RH, CS_BPT = 4 * CS_RH, CS_UV = CS_BPT + 64 * CS_TS * 2, CS_PC = CS_UV + 64 * CS_TS * 2, CS_OPS = CS_PC + 256;
constexpr int CS_FR = 3 * CS_OPS, CS_FRSZ = 7 * 512, CS_RAWB = CS_FR + 2 * CS_FRSZ, CS_RAWSZ = 3 * 1024, CS_END = CS_RAWB + 4 * 3 * CS_RAWSZ;
static_assert(CS_END + 4 * 256 <= RING_BYTES, "chunked scan LDS");
#define CS_MFMA(a_, b_, c_) __builtin_amdgcn_mfma_f32_16x16x32_bf16(a_, b_, c_, 0, 0, 0)
#define CS_MFMA16(a_, b_, c_) __builtin_amdgcn_mfma_f32_16x16x16bf16_1k(a_, b_, c_, 0, 0, 0)
__device__ __forceinline__ bf16x4 cs_cvt4(const f32x4 x) { const u32x2 w = (u32x2){cvt_pk_bf16(x[0], x[1]), cvt_pk_bf16(x[2], x[3])}; return __builtin_bit_cast(bf16x4, w); }
__device__ __forceinline__ void scan_phase_chunked(const Frame& F, int j, const bf16* Vsrc) {
    const bf16* R = (const bf16*)(F.ws + WS_R); const bf16* K = (const bf16*)(F.ws + WS_K);
    const unsigned short* E = (const unsigned short*)(F.ws + WS_E); const unsigned short* AA = (const unsigned short*)(F.ws + WS_AA);
    bf16* Y = (bf16*)(F.ws + WS_Y); const float* ST = (const float*)(F.ws + WS_STATS);
    LAS unsigned char* L = F.lds;
    PHASE_IDS();
    const int q4 = lane >> 4, cc = lane & 15;
    const f32x4 z4 = (f32x4){0.f, 0.f, 0.f, 0.f};
    const bf16x4 zf4 = (bf16x4){0, 0, 0, 0};
    for (int s = blockIdx.x; s < 256; s += F.G) {
        const int b = s >> 6, h = (s >> 1) & 31, d = s & 1;
        bf16* Yd = Y + (size_t)d * NT * DM;
        const int kch = ((wave - 4) & 3) * 16 + cc, ch = h * 64 + kch;
        float kkw = in_ptr(F, I_KK)[(size_t)j * DM + ch], kaw = in_ptr(F, I_KA)[(size_t)j * DM + ch];
        asm volatile("" : "+v"(kkw), "+v"(kaw));
#define CS_ROW(chunk_, tl_) ((size_t)b * TPB + ((d == 0) ? ((chunk_) * 16 + (tl_)) : (((chunk_) < 16) ? (CTXL - 1 - ((chunk_) * 16 + (tl_))) : ((TPB + CTXL - 1) - ((chunk_) * 16 + (tl_))))))
        const int pw = (wave - 4) & 3;
        LAS unsigned char* RW = L + CS_RAWB + pw * 3 * CS_RAWSZ;
        LAS unsigned char* GT = L + CS_END + pw * 256;
        const char* dbase[3]; unsigned dpitch[3];
#pragma unroll
        for (int jd = 0; jd < 3; ++jd) { int g = jd * 64 + lane; if (g > 175) g = 175;
            if (g < 160) { const int a = g >> 5, t = (g >> 1) & 15, hf = g & 1, dro = (d == 0) ? t : 15 - t;
                const char* ab = (a == 0) ? (const char*)R : (a == 1 ? (const char*)K : (a == 2 ? (const char*)Vsrc : (a == 3 ? (const char*)E : (const char*)AA)));
                dpitch[jd] = (a < 3) ? (unsigned)(DM * 2) : 8192u;
                dbase[jd] = ab + (size_t)dro * dpitch[jd] + (size_t)((h * 64 + pw * 16 + hf * 8) * 2 + (a < 3 ? 0 : d * DM * 2)); }
            else { const int t = g - 160, dro = (d == 0) ? t : 15 - t; dpitch[jd] = 1024u; dbase[jd] = (const char*)ST + (size_t)((dro * 32 + h) * 32); } }
#define CS_RAW(chunk_, slot_) do { const unsigned rb_ = (unsigned)__builtin_amdgcn_readfirstlane((int)CS_ROW(chunk_, (d == 0) ? 0 : 15)); \
            _Pragma("unroll") for (int jd = 0; jd < 3; ++jd) \
                __builtin_amdgcn_global_load_lds((const unsigned*)(dbase[jd] + (size_t)rb_ * dpitch[jd]), (LAS unsigned*)(RW + (slot_) * CS_RAWSZ + jd * 1024), 16, 0, 0); } while (0)
        const int rd_off = cc * 2;
#define CS_GET16(slot_, a_, tl_) (*(const LAS unsigned short*)(RW + (slot_) * CS_RAWSZ + (a_) * 512 + rd_off + (tl_) * 32))
        f32x4 S[4];
#pragma unroll
        for (int nb = 0; nb < 4; ++nb) S[nb] = z4;
        const int vb = (wave & 3) * 16;
        if (wave >= 4) { CS_RAW(0, 0); CS_RAW(1, 1); }
        asm volatile("s_waitcnt lgkmcnt(0)" ::: "memory"); __builtin_amdgcn_s_barrier(); asm volatile("" ::: "memory");
#define CS_BAR() do { asm volatile("s_waitcnt lgkmcnt(0)" ::: "memory"); __builtin_amdgcn_s_barrier(); asm volatile("" ::: "memory"); } while (0)
#define CS_PROD(P, it, m3) do { \
                const bool do_ops = it < 272; \
                LAS unsigned char* O = L + (m3) * CS_OPS; \
                if (do_ops) { \
                    float rf[4], kf[4], wf[4], af[4], nf[4], cp[4]; unsigned short vr[4]; \
                    asm volatile("s_waitcnt vmcnt(3)" ::: "memory"); \
_Pragma("unroll") \
                    for (int q = 0; q < 4; ++q) { const int tl_ = 4 * q4 + q, sl_ = (m3); rf[q] = bf2f(CS_GET16(sl_, 0, tl_)); kf[q] = bf2f(CS_GET16(sl_, 1, tl_)); vr[q] = CS_GET16(sl_, 2, tl_); wf[q] = __expf(-h2f(CS_GET16(sl_, 3, tl_))); af[q] = h2f(CS_GET16(sl_, 4, tl_)); nf[q] = *(const LAS float*)(RW + sl_ * CS_RAWSZ + 2560 + tl_ * 16); } \
                    asm volatile("s_waitcnt lgkmcnt(0)" ::: "memory"); CS_RAW(it + 2 < 272 ? it + 2 : 271, ((m3) + 2) % 3); \
                    cp[0] = wf[0]; cp[1] = cp[0] * wf[1]; cp[2] = cp[1] * wf[2]; cp[3] = cp[2] * wf[3]; \
                      \
                    const auto s16 = __builtin_amdgcn_permlane16_swap(__float_as_uint(cp[3]), __float_as_uint(cp[3]), false, false);     \
                    const float ge = __uint_as_float(s16[0]), pp = ge * __uint_as_float(s16[1]); \
                    const auto s32 = __builtin_amdgcn_permlane32_swap(__float_as_uint(pp), __float_as_uint(pp), false, false);              \
                    const float p01 = __uint_as_float(s32[0]), pc = p01 * __uint_as_float(s32[1]); \
                    const float ex = ((q4 & 2) ? p01 : 1.0f) * ((q4 & 1) ? ge : 1.0f); \
_Pragma("unroll") \
                    for (int q = 0; q < 4; ++q) { const int tl = 4 * q4 + q; \
                        const float Pt = ex * cp[q], Pm = (q == 0) ? ex : ex * cp[q > 0 ? q - 1 : 0], rP = __builtin_amdgcn_rcpf(Pt), dc = pc * rP; \
                        const float kk = kf[q] * kkw * nf[q], kd = kf[q] * (1.0f + (af[q] - 1.0f) * kaw), bb = kk * af[q]; \
                        const unsigned p0 = cvt_pk_bf16(-kk * Pm, rf[q] * Pt), p1 = cvt_pk_bf16(bb * rP, kd * rP), p2 = cvt_pk_bf16(bb * dc, kd * dc); \
                        *(LAS unsigned short*)(O + CS_AL + (tl * CS_KS + kch) * 2) = (unsigned short)p0; *(LAS unsigned short*)(O + CS_RH + (tl * CS_KS + kch) * 2) = (unsigned short)(p0 >> 16); \
                        *(LAS unsigned short*)(O + CS_BE + (tl * CS_KS + kch) * 2) = (unsigned short)p1; *(LAS unsigned short*)(O + CS_KA + (tl * CS_KS + kch) * 2) = (unsigned short)(p1 >> 16); \
                        *(LAS unsigned short*)(O + CS_BPT + (kch * CS_TS + tl) * 2) = (unsigned short)p2; *(LAS unsigned short*)(O + CS_BPT + (kch * CS_TS + 16 + tl) * 2) = (unsigned short)(p2 >> 16); \
                        *(LAS unsigned short*)(O + CS_UV + (kch * CS_TS + 16 + tl) * 2) = vr[q]; } \
                    if (q4 == 0) *(LAS float*)(O + CS_PC + kch * 4) = pc; \
                } \
        } while (0)
#define CS_NMAT(P, it, m3) do { \
                if (it >= 1 && it < 273) { \
                    const LAS unsigned char* On = L + (((m3) + 2) % 3) * CS_OPS; LAS unsigned char* FR = L + CS_FR + ((it + 1) & 1) * CS_FRSZ; \
                    LAS bf16x4* fr = (LAS bf16x4*)FR + lane; \
                    if (wave == 0) { \
                        const bf16x8 be0 = *(const LAS bf16x8*)(On + CS_BE + (cc * CS_KS + q4 * 8) * 2), be1 = *(const LAS bf16x8*)(On + CS_BE + (cc * CS_KS + 32 + q4 * 8) * 2); \
                        const bf16x8 al0 = *(const LAS bf16x8*)(On + CS_AL + (cc * CS_KS + q4 * 8) * 2), al1 = *(const LAS bf16x8*)(On + CS_AL + (cc * CS_KS + 32 + q4 * 8) * 2); \
                        f32x4 P = CS_MFMA(be1, al1, CS_MFMA(be0, al0, z4)); \
                        f32x4 Q = CS_MFMA(al1, be1, CS_MFMA(al0, be0, z4)); \
                        _Pragma("unroll") for (int jj = 0; jj < 4; ++jj) { const int rr = 4 * q4 + jj; if (!(rr < cc)) P[jj] = 0.f; if (!(cc < rr)) Q[jj] = 0.f; } \
                        bf16x4 pb = cs_cvt4(P), qb = cs_cvt4(Q); fr[1 * 64] = pb; \
                        _Pragma("unroll") for (int p = 0; p < 3; ++p) { const f32x4 P2 = CS_MFMA16(qb, pb, z4), Q2 = CS_MFMA16(pb, qb, z4); \
                            pb = cs_cvt4(P2); qb = cs_cvt4(Q2); fr[(2 + p) * 64] = pb; } \
                    } else { \
                        const int lo_ = (wave == 2) ? CS_BE : CS_KA, ro_ = (wave == 1) ? CS_AL : CS_RH, slot_ = (wave == 1) ? 0 : ((wave == 2) ? 5 : 6); \
                        const bf16x8 x0 = *(const LAS bf16x8*)(On + lo_ + (cc * CS_KS + q4 * 8) * 2), x1 = *(const LAS bf16x8*)(On + lo_ + (cc * CS_KS + 32 + q4 * 8) * 2); \
                        const bf16x8 y0 = *(const LAS bf16x8*)(On + ro_ + (cc * CS_KS + q4 * 8) * 2), y1 = *(const LAS bf16x8*)(On + ro_ + (cc * CS_KS + 32 + q4 * 8) * 2); \
                        f32x4 nn = CS_MFMA(x1, y1, CS_MFMA(x0, y0, z4)); \
                        _Pragma("unroll") for (int jj = 0; jj < 4; ++jj) { const int rr = 4 * q4 + jj; const bool keep = (wave == 1) ? (rr < cc) : (rr <= cc); if (!keep) nn[jj] = 0.f; } \
                        fr[slot_ * 64] = cs_cvt4(nn); \
                    } \
                } \
        } while (0)
#define CS_CONS(it, m3) do { \
                const int c = it - 2; \
                const LAS unsigned char* O = L + (((m3) + 1) % 3) * CS_OPS; const LAS bf16x4* fr = (const LAS bf16x4*)(L + CS_FR + (c & 1) * CS_FRSZ) + lane; \
                bf16x4 aA[4], aR[4], bu[4], bv[4]; f32x4 pc4[4]; \
_Pragma("unroll") \
                for (int nb = 0; nb < 4; ++nb) { aA[nb] = *(const LAS bf16x4*)(O + CS_AL + (cc * CS_KS + 16 * nb + 4 * q4) * 2); aR[nb] = *(const LAS bf16x4*)(O + CS_RH + (cc * CS_KS + 16 * nb + 4 * q4) * 2); \
                    bu[nb] = *(const LAS bf16x4*)(O + CS_BPT + ((16 * nb + cc) * CS_TS + 4 * q4) * 2); bv[nb] = *(const LAS bf16x4*)(O + CS_BPT + ((16 * nb + cc) * CS_TS + 16 + 4 * q4) * 2); \
                    pc4[nb] = *(const LAS f32x4*)(O + CS_PC + (16 * nb + 4 * q4) * 4); } \
                const bf16x4 vT = *(const LAS bf16x4*)(O + CS_UV + ((vb + cc) * CS_TS + 16 + 4 * q4) * 2); \
                const bf16x4 fN2 = fr[0], fP1 = fr[64], fP2 = fr[128], fP4 = fr[192], fP8 = fr[256], fN3 = fr[320], fN4 = fr[384]; \
                f32x4 X = z4, Yt = z4; \
_Pragma("unroll") \
                for (int nb = 0; nb < 4; ++nb) { const bf16x4 sb = cs_cvt4(S[nb]); X = CS_MFMA16(aA[nb], sb, X); Yt = CS_MFMA16(aR[nb], sb, Yt); } \
                X = CS_MFMA16(fN2, vT, X); \
                X = CS_MFMA16(fP1, cs_cvt4(X), X); X = CS_MFMA16(fP2, cs_cvt4(X), X); X = CS_MFMA16(fP4, cs_cvt4(X), X); X = CS_MFMA16(fP8, cs_cvt4(X), X); \
                const bf16x4 ub = cs_cvt4(X); \
_Pragma("unroll") \
                for (int nb = 0; nb < 4; ++nb) S[nb] = CS_MFMA16(bv[nb], vT, CS_MFMA16(bu[nb], ub, S[nb] * pc4[nb])); \
                Yt = CS_MFMA16(fN4, vT, CS_MFMA16(fN3, ub, Yt)); \
                { const unsigned y01 = cvt_pk_bf16(Yt[0], Yt[1]), y23 = cvt_pk_bf16(Yt[2], Yt[3]); \
                  char* yb = ybase + (size_t)__builtin_amdgcn_readfirstlane((int)CS_ROW(c, (d == 0) ? 0 : 15)) * (DM * 2);     \
                  *(bf16*)(yb + yo) = (bf16)y01; *(bf16*)(yb + (yo + ystep)) = (bf16)(y01 >> 16); *(bf16*)(yb + (yo + 2 * ystep)) = (bf16)y23; *(bf16*)(yb + (yo + 3 * ystep)) = (bf16)(y23 >> 16); } \
        } while (0)
        if (wave >= 4) {
            for (int it3 = 0; it3 < 273; it3 += 3) { CS_PROD(A, it3, 0); CS_BAR(); CS_PROD(B, (it3 + 1), 1); CS_BAR(); CS_PROD(C, (it3 + 2), 2); CS_BAR(); }
            CS_BAR();
        } else {
            char* ybase = (char*)Yd + (h * 64) * 2;
            const unsigned yo = (unsigned)(((d == 0) ? 4 * q4 : 15 - 4 * q4) * (DM * 2) + (vb + cc) * 2), ystep = (d == 0) ? (unsigned)(DM * 2) : (unsigned)(-(DM * 2));
            CS_BAR(); CS_NMAT(D, 1, 1); CS_BAR();
            for (int it3 = 2; it3 < 272; it3 += 3) { CS_CONS(it3, 2); CS_NMAT(A, it3, 2); CS_BAR(); CS_CONS((it3 + 1), 0); CS_NMAT(B, (it3 + 1), 0); CS_BAR(); CS_CONS((it3 + 2), 1); CS_NMAT(C, (it3 + 2), 1); CS_BAR(); }
            CS_CONS(272, 2); CS_NMAT(E, 272, 2); CS_BAR(); CS_CONS(273, 0); CS_BAR();
        }
#undef CS_PROD
#undef CS_CONS
#undef CS_NMAT
#undef CS_BAR
        asm volatile("s_waitcnt vmcnt(0)" ::: "memory");
#undef CS_RAW
#undef CS_DMA
#undef CS_GET16
#undef CS_ROW
    }
}
__device__ __forceinline__ void post_phase(const Frame& F, int j, const bf16* Vsrc) {
    const bf16* Y0 = (const bf16*)(F.ws + WS_Y); const bf16* Y1 = Y0 + (size_t)NT * DM; const float* ST = (const float*)(F.ws + WS_STATS);
    const bf16* Gg = (const bf16*)(F.ws + WS_G); bf16* OA = (bf16*)(F.ws + WS_OA);
    const float* lg = in_ptr(F, I_LNG) + (size_t)j * DM; const float* lb = in_ptr(F, I_LNB) + (size_t)j * DM;
    PHASE_IDS();
    f32x4 lgv[4][2], lbv[4][2];
#pragma unroll
    for (int q = 0; q < 4; ++q) { const int c0 = q * 512 + lane * 8; lgv[q][0] = *(const f32x4*)(lg + c0); lgv[q][1] = *(const f32x4*)(lg + c0 + 4); lbv[q][0] = *(const f32x4*)(lb + c0); lbv[q][1] = *(const f32x4*)(lb + c0 + 4); }
    for (int row = gw; row < NT; row += NGW) {
        const size_t ro = (size_t)row * DM + lane * 8;
        u32x4 y0[4], y1[4], vv[4], gg[4]; f32x2 bs[4];
#pragma unroll
        for (int q = 0; q < 4; ++q) { y0[q] = *(const u32x4*)(Y0 + ro + q * 512); y1[q] = *(const u32x4*)(Y1 + ro + q * 512); vv[q] = *(const u32x4*)(Vsrc + ro + q * 512); gg[q] = *(const u32x4*)(Gg + ro + q * 512);
            { const float* sp = ST + ((size_t)row * 32 + q * 8 + (lane >> 3)) * 8; bs[q] = (f32x2){sp[3], sp[6]}; } }
#pragma unroll
        for (int q = 0; q < 4; ++q) {
            float y[8]; float sm = 0.f;
#pragma unroll
            for (int e = 0; e < 4; ++e) { y[2 * e] = bflo(y0[q][e]) + bflo(y1[q][e]); y[2 * e + 1] = bfhi(y0[q][e]) + bfhi(y1[q][e]); sm += y[2 * e] + y[2 * e + 1]; }
            const float mean = red8(sm) * (1.0f / 64.0f); float qq = 0.f;
#pragma unroll
            for (int e = 0; e < 8; ++e) { y[e] -= mean; qq += y[e] * y[e]; }
            const float rstd = rsqrtf(red8(qq) * (1.0f / 64.0f) + 64e-5f), bsum = bs[q].x + bs[q].y;
            const f32x4 l0 = lgv[q][0], l1 = lgv[q][1], b0 = lbv[q][0], b1 = lbv[q][1];
            float o[8];
#pragma unroll
            for (int e = 0; e < 4; ++e) {
                const float v0 = bflo(vv[q][e]), v1 = bfhi(vv[q][e]), g0 = bflo(gg[q][e]), g1 = bfhi(gg[q][e]);
                const float la = (2 * e < 4) ? l0[2 * e] : l1[2 * e - 4], lc = (2 * e + 1 < 4) ? l0[2 * e + 1] : l1[2 * e + 1 - 4];
                const float ba = (2 * e < 4) ? b0[2 * e] : b1[2 * e - 4], bc = (2 * e + 1 < 4) ? b0[2 * e + 1] : b1[2 * e + 1 - 4];
                o[2 * e] = (y[2 * e] * rstd * la + ba + bsum * v0) * g0; o[2 * e + 1] = (y[2 * e + 1] * rstd * lc + bc + bsum * v1) * g1; }
            u32x4 w; w.x = pk2(o[0], o[1]); w.y = pk2(o[2], o[3]); w.z = pk2(o[4], o[5]); w.w = pk2(o[6], o[7]);
            *(u32x4*)(OA + ro + q * 512) = w;
        }
    }
}

#ifndef DUP_SCAN
#define DUP_SCAN 1
#endif
#ifndef DUP_ELT
#define DUP_ELT 1
#endif
#ifndef DUP_ATT
#define DUP_ATT 1
#endif
#ifndef DUP_UP
#define DUP_UP 1
#endif
#ifndef DUP_PROJ
#define DUP_PROJ 1
#endif
#ifndef DUP_RES
#define DUP_RES 1
#endif
#ifndef DUP_L2
#define DUP_L2 1
#endif
#ifndef DUP_P0
#define DUP_P0 1
#endif
#ifndef DUP_BAR
#define DUP_BAR 1
#endif
#define REP(n) _Pragma("nounroll") for (int rep_ = 0; rep_ < opaque_s(n); ++rep_)
__global__ void __launch_bounds__(512, 2) mega_fwd(Args args) {
    extern __shared__ __attribute__((aligned(16))) unsigned char lds[];
    Frame F;
    F.lds = (LAS unsigned char*)lds; F.ldsg = (char*)lds;
    F.G = gridDim.x; { const int bx = blockIdx.x; F.vcu = (F.G % 8 == 0) ? (bx % 8) * (F.G / 8) + bx / 8 : bx; }
    F.NGW = F.G * 8; F.wave = __builtin_amdgcn_readfirstlane((int)(threadIdx.x >> 6));
    F.ws = args.ws;
    unsigned char* ws = args.ws;
    volatile LAS unsigned* MISC = (volatile LAS unsigned*)(F.lds + MISC_OFF);
    for (int u = threadIdx.x; u < (LDS_BYTES - RING_BYTES) / 4; u += 512) ((LAS unsigned*)(F.lds + RING_BYTES))[u] = 0u;
    __syncthreads();
    if (threadIdx.x == 0) { LAS unsigned long long* tab = (LAS unsigned long long*)(F.lds + PTAB_OFF);
#pragma unroll
        for (int i = 0; i < 38; ++i) tab[i] = (unsigned long long)args.in[i];
        tab[38] = (unsigned long long)args.out; }
    __syncthreads();
    XcdBarrier bar = xcd_barrier_post((unsigned*)(ws + WS_CTL) + CW_BAR, MISC + 8); bar.wave = F.wave;
#define GRID_BAR() do { REP(DUP_BAR) xcd_barrier(bar); } while (0)
    const float* MOD = (const float*)(ws + WS_CTL) + CW_MOD;
    const int c = (int)blockIdx.x;

    REP(DUP_P0) p0_prologue(F);
    GRID_BAR();
    mod_finalize(F);
    GRID_BAR();

    for (int layer = 0; layer < 4; ++layer) {
        const int lp = layer >> 1;
        const bool last = (layer == 3);
        REP(DUP_ELT) norm_phase(F, layer, 0, layer == 0, layer == 0 ? -1 : ((layer - 1) * 5 * 12288 + 5 * DM), false);
        GRID_BAR();
        if ((layer & 1) == 0) {
            {
                pg8::SchedInproj S{(const char*)(ws + WS_H), (const char*)(ws + WS_WQKV + (size_t)lp * 10 * MiB), (const char*)(ws + WS_WPQ + (size_t)lp * 4 * MiB), F.G, c};
                pg8::EpiInproj E{(bf16*)(ws + WS_QKV), (bf16*)(ws + WS_T), in_ptr(F, I_QG) + (size_t)lp * 128, in_ptr(F, I_KG) + (size_t)lp * 128,
                                 (const float*)(ws + WS_ROPEC), (const float*)(ws + WS_ROPES), F.lds + EX_OFF};
                REP(DUP_PROJ) pg8::gemm_phase(F.lds, F.wave, DM, DM, S, E);
            }
            GRID_BAR();
            REP(DUP_ATT) {
                {
                pg8::SchedDft S{(const char*)(ws + WS_ADFT), (const char*)(ws + WS_T), F.G, F.vcu};
                pg8::EpiStore E{(bf16*)(ws + WS_MIX), DM};
                pg8::gemm_phase(F.lds, F.wave, 8192, TLD, S, E);
                }
                __syncthreads();
                attn_phase(F, lp);
            }
            if (F.G == 256 && F.vcu < 128) { deferred_transposes(F, layer >> 1); }
            GRID_BAR();
        } else {
            REP(DUP_ELT) mixes_phase(F, lp);
            GRID_BAR();
            bf16* Vdst = (bf16*)(ws + (lp == 0 ? WS_VFIRST : WS_V));
            {
                pg8::SchedRkvl S{(const char*)(ws + WS_MIXES), (const char*)(ws + WS_WRKVO + (size_t)lp * 32 * MiB), (const char*)(ws + WS_L1 + (size_t)lp * 4 * MiB), F.G, c};
                pg8::EpiRkvl E{(bf16*)(ws + WS_R), (bf16*)(ws + WS_K), Vdst, (bf16*)(ws + WS_L)};
                REP(DUP_PROJ) pg8::gemm_phase(F.lds, F.wave, DM, DM, S, E);
            }
            if (F.G == 256 && layer == 1 && c >= 112) tail_transposes(F, 1, 0, 32 * 352 + 88 * 64, c - 112, 144);
            GRID_BAR();
            {
                pg8::SchedLora2 S{(const char*)(ws + WS_L), (const char*)(ws + WS_L2 + (size_t)lp * 6 * MiB), lp == 0 ? 40 : 48, F.G, c};
                pg8::EpiLora2 E{(unsigned short*)(ws + WS_E), (unsigned short*)(ws + WS_AA), (bf16*)(ws + WS_G), (bf16*)(ws + WS_V), (const bf16*)(ws + WS_VFIRST),
                                in_ptr(F, I_DW0) + (size_t)lp * 2 * DM, in_ptr(F, I_IA0) + (size_t)lp * 2 * DM, in_ptr(F, I_V0)};
                pg8::gemm_phase(F.lds, F.wave, 1024, 256, S, E);
                if (DUP_L2 > 1) { GRID_BAR(); pg8::SchedLora2 S2{(const char*)(ws + WS_L), (const char*)(ws + WS_L2 + (size_t)lp * 6 * MiB), 40, F.G, c}; pg8::gemm_phase(F.lds, F.wave, 1024, 256, S2, E); }
            }
            GRID_BAR();
            scan_prep_phase(F, lp, Vdst);
            GRID_BAR();
            REP(DUP_SCAN) scan_phase_chunked(F, lp, Vdst);
            GRID_BAR();
            REP(DUP_ELT) post_phase(F, lp, Vdst);
            GRID_BAR();
        }
        {
            const char* Aop = (const char*)(ws + ((layer & 1) == 0 ? WS_MIX : WS_OA));
            const char* Bop = (const char*)(ws + ((layer & 1) == 0 ? WS_WOUT + (size_t)lp * 8 * MiB : WS_WRKVO + (size_t)(lp * 4 + 3) * 8 * MiB));
            pg8::SchedRes S{Aop, Bop, (size_t)256 * DM * 2, (size_t)256 * DM * 2, 32, last ? 1 : 0, F.G, c};
            pg8::EpiResid E{(bf16*)(ws + WS_X), MOD + (size_t)layer * 5 * 12288 + 2 * DM, (unsigned short*)(ws + WS_PART)};
            pg8::gemm_phase(F.lds, F.wave, DM, DM, S, E);
            if (DUP_RES > 1) { GRID_BAR(); pg8::EpiResid E0{(bf16*)(ws + WS_X), (const float*)(ws + WS_CTL) + 262144, (unsigned short*)(ws + WS_PART)}; pg8::gemm_phase(F.lds, F.wave, DM, DM, S, E0); }
        }
        GRID_BAR();
        REP(DUP_ELT) norm_phase(F, layer, 1, false, last ? -1 : (layer * 5 * 12288 + 2 * DM), last);
        GRID_BAR();
        {
            pg8::SchedSimple S{(const char*)(ws + WS_H), (const char*)(ws + WS_WUP + (size_t)layer * 44 * MiB), (size_t)256 * DM * 2, (size_t)256 * DM * 2, last ? 64 : NPAN, 44, 32, F.G, c};
            pg8::EpiUpConv E{(bf16*)(ws + WS_ACT), (bf16*)(ws + WS_HALO), in_ptr(F, I_CW) + (size_t)layer * 3 * DFF2, in_ptr(F, I_CB) + (size_t)layer * DFF2, F.lds + EX_OFF};
            REP(DUP_UP) pg8::gemm_phase(F.lds, F.wave, DM, DM, S, E);
        }
        if (F.G == 256 && layer < 2 && c >= 176) tail_transposes(F, 2, layer * 8448, layer * 8448 + 8448, c - 176, 80);
        GRID_BAR();
        ffn_fixup_phase(F, layer);
        GRID_BAR();
        {
            pg8::SchedRes S{(const char*)(ws + WS_ACT), (const char*)(ws + WS_WDN + (size_t)layer * 22 * MiB), (size_t)256 * DFF * 2, (size_t)256 * DFF * 2, 88, last ? 1 : 0, F.G, c};
            pg8::EpiResid E{(bf16*)(ws + WS_X), MOD + (size_t)layer * 5 * 12288 + 5 * DM, (unsigned short*)(ws + WS_PART)};
            pg8::gemm_phase(F.lds, F.wave, DFF, DFF, S, E);
            if (DUP_RES > 1) { GRID_BAR(); pg8::EpiResid E0{(bf16*)(ws + WS_X), (const float*)(ws + WS_CTL) + 262144, (unsigned short*)(ws + WS_PART)}; pg8::gemm_phase(F.lds, F.wave, DFF, DFF, S, E0); }
        }
        GRID_BAR();
    }
    final_norm_phase(F);
}

extern "C" void kernel_launch(void* const* d_in, const int* in_sizes, int n_in, void* d_out, int out_size, void* d_ws, size_t ws_size, hipStream_t stream) {
    static int grid = 0;
    if (grid == 0) {
        if (n_in != 38 || in_sizes[0] != NBATCH * SEQ * DM || out_size != NBATCH * SEQ * DM || ws_size < WS_END) {
            fprintf(stderr, "kernel_launch: shape/workspace mismatch (n_in %d, ws %zu, need %zu); nothing launched\n", n_in, ws_size, (size_t)WS_END); grid = -1; return; }
        int dev = 0, cus = 0;
        if (hipGetDevice(&dev) != hipSuccess || hipDeviceGetAttribute(&cus, hipDeviceAttributeMultiprocessorCount, dev) != hipSuccess) { grid = -1; return; }
        if (hipFuncSetAttribute((const void*)mega_fwd, hipFuncAttributeMaxDynamicSharedMemorySize, LDS_BYTES) != hipSuccess) { fprintf(stderr, "kernel_launch: hipFuncSetAttribute failed\n"); grid = -1; return; }
        int per_cu = 0;
        if (hipOccupancyMaxActiveBlocksPerMultiprocessor(&per_cu, (const void*)mega_fwd, 512, LDS_BYTES) != hipSuccess || per_cu < 1) { fprintf(stderr, "kernel_launch: occupancy query says %d\n", per_cu); }
        (void)hipGetLastError();
        grid = cus;
    }
    if (grid < 0) return;
    if (hipMemsetAsync((char*)d_ws + WS_CTL, 0, CTL_ZERO_BYTES, stream) != hipSuccess) return;
    Args a{};
    for (int i = 0; i < 38; ++i) a.in[i] = (const float*)d_in[i];
    a.out = (float*)d_out; a.ws = (unsigned char*)d_ws;
    hipLaunchKernelGGL(mega_fwd, dim3(grid), dim3(512), LDS_BYTES, stream, a);
    const hipError_t le = hipPeekAtLastError();
    if (le != hipSuccess) fprintf(stderr, "kernel_launch: launch failed: %s\n", hipGetErrorName(le));
}
```
